# Optimizing an MI355X kernel written in HIP

```python
import math
import jax, jax.numpy as jnp
from jax import lax
import numpy as np

D_MODEL = 1024
BATCH = 4
SEQ = 4096
DEPTH = 2

N_META = 16
D_FF = 2816
NORM_EPS = 1e-6
NEG_INF = -1e30
SWA_Q_HEADS = 8
SWA_KV_HEADS = 2
SWA_HEAD_DIM = 64
SWA_WINDOW = 128
SWA_BLOCK = 128
REL_BUCKETS = 32
REL_MAX_DIST = 128
SWA_Q_DIM = SWA_Q_HEADS * SWA_HEAD_DIM
SWA_KV_DIM = SWA_KV_HEADS * SWA_HEAD_DIM
DN_HEADS = 4
DN_HEAD_DIM = 128
DN_DIM = DN_HEADS * DN_HEAD_DIM
DN_CONV = 4
DN_CHUNK = 64
GLA_HEADS = 4
GLA_KEY_DIM = D_MODEL // 2
GLA_VAL_DIM = D_MODEL
GLA_GATE_RANK = 16
GLA_GATE_NORM = 16.0
GLA_CHUNK = 64
N_EVEN = (DEPTH + 1) // 2
N_ODD = DEPTH // 2
EVEN_IN_SIZES = (SWA_Q_DIM, SWA_KV_DIM, SWA_KV_DIM, DN_DIM, DN_DIM, DN_DIM, DN_DIM, DN_HEADS, DN_HEADS)
EVEN_IN_DIM = sum(EVEN_IN_SIZES)
EVEN_MIX_DIM = SWA_Q_DIM + DN_DIM
ODD_IN_SIZES = (GLA_KEY_DIM, GLA_KEY_DIM, GLA_VAL_DIM, GLA_VAL_DIM, GLA_GATE_RANK)
ODD_IN_DIM = sum(ODD_IN_SIZES)

kernel_name = "hybrid_swa_deltanet_gla_macaron"


def _split(t, sizes):
    idx = np.cumsum(sizes)[:-1].tolist()
    return jnp.split(t, idx, axis=-1)


def rms_norm(x, w):
    x32 = x.astype(jnp.float32)
    y = x32 * lax.rsqrt(jnp.mean(x32 * x32, axis=-1, keepdims=True) + NORM_EPS)
    return (y * w.astype(jnp.float32)).astype(x.dtype)


def l2_norm(x):
    return x * lax.rsqrt(jnp.sum(x * x, axis=-1, keepdims=True) + 1e-6)


def swiglu(x, w_gate, w_up, w_down):
    return (jax.nn.silu(x @ w_gate) * (x @ w_up)) @ w_down


def causal_depthwise_conv(x, w):
    k = w.shape[0]
    return lax.conv_general_dilated(x, w[:, None, :].astype(x.dtype), window_strides=(1,),
                                    padding=[(k - 1, 0)], dimension_numbers=('NWC', 'WIO', 'NWC'),
                                    feature_group_count=x.shape[-1])


def t5_bucket(rel):
    n = jnp.maximum(rel, 0)
    max_exact = REL_BUCKETS // 2
    n_f = jnp.maximum(n, 1).astype(jnp.float32)
    large = max_exact + (jnp.log(n_f / max_exact) / math.log(REL_MAX_DIST / max_exact)
                         * (REL_BUCKETS - max_exact)).astype(jnp.int32)
    large = jnp.minimum(large, REL_BUCKETS - 1)
    return jnp.where(n < max_exact, n, large)


def to_chunks(t, chunk):
    pad = chunk - N_META
    t = jnp.pad(t, [(0, 0), (pad, 0)] + [(0, 0)] * (t.ndim - 2))
    b, lp = t.shape[:2]
    t = t.reshape(b, lp // chunk, chunk, *t.shape[2:])
    return jnp.moveaxis(t, 3, 1)


def from_chunks(t, chunk):
    t = jnp.moveaxis(t, 1, 3)
    b, n, c = t.shape[:3]
    return t.reshape(b, n * c, *t.shape[3:])[:, chunk - N_META:]


def _chunk_first(t):
    return jnp.moveaxis(t, 2, 0)


def sliding_window_attention(q, k, v, sinks, rel_table):
    f32 = jnp.float32
    b, l = q.shape[:2]
    g = SWA_Q_HEADS // SWA_KV_HEADS
    dh = SWA_HEAD_DIM
    pad = SWA_BLOCK - N_META
    lp = l + pad
    nb = lp // SWA_BLOCK
    padw = ((0, 0), (pad, 0), (0, 0), (0, 0))
    qb = jnp.pad(q.astype(f32), padw).reshape(b, nb, SWA_BLOCK, SWA_KV_HEADS, g, dh)
    kb = jnp.pad(k.astype(f32), padw).reshape(b, nb, SWA_BLOCK, SWA_KV_HEADS, dh)
    vb = jnp.pad(v.astype(f32), padw).reshape(b, nb, SWA_BLOCK, SWA_KV_HEADS, dh)
    prev = ((0, 0), (1, 0), (0, 0), (0, 0), (0, 0))
    k_band = jnp.concatenate([jnp.pad(kb[:, :-1], prev), kb], axis=2)
    v_band = jnp.concatenate([jnp.pad(vb[:, :-1], prev), vb], axis=2)
    k_meta = k[:, :N_META].astype(f32)
    v_meta = v[:, :N_META].astype(f32)
    scale = dh ** -0.5
    s_band = jnp.einsum('bnqhgd,bnkhd->bhgnqk', qb, k_band) * scale
    s_meta = jnp.einsum('bnqhgd,bmhd->bhgnqm', qb, k_meta) * scale
    blk = jnp.arange(nb)[:, None]
    pos_q = blk * SWA_BLOCK + jnp.arange(SWA_BLOCK)[None, :] - pad
    pos_kb = blk * SWA_BLOCK + jnp.arange(2 * SWA_BLOCK)[None, :] - SWA_BLOCK - pad
    rel_b = pos_q[:, :, None] - pos_kb[:, None, :]
    mask_b = (pos_kb[:, None, :] >= N_META) & (rel_b >= 0) & (rel_b < SWA_WINDOW)
    rel_m = pos_q[:, :, None] - jnp.arange(N_META)[None, None, :]
    mask_m = rel_m >= 0
    table = rel_table.astype(f32)

    def rel_bias(rel):
        bias = table[t5_bucket(rel)]
        return jnp.moveaxis(bias, -1, 0).reshape(SWA_KV_HEADS, g, *rel.shape)

    s_band = jnp.where(mask_b, s_band + rel_bias(rel_b), NEG_INF)
    s_meta = jnp.where(mask_m, s_meta + rel_bias(rel_m), NEG_INF)
    sink = jnp.broadcast_to(sinks.astype(f32).reshape(SWA_KV_HEADS, g, 1, 1, 1),
                            (b, SWA_KV_HEADS, g, nb, SWA_BLOCK, 1))
    p = jax.nn.softmax(jnp.concatenate([s_band, s_meta, sink], axis=-1), axis=-1)
    nk = 2 * SWA_BLOCK
    o = (jnp.einsum('bhgnqk,bnkhd->bnqhgd', p[..., :nk], v_band)
         + jnp.einsum('bhgnqm,bmhd->bnqhgd', p[..., nk:nk + N_META], v_meta))
    return o.reshape(b, lp, SWA_Q_DIM)[:, pad:]


def chunk_gated_delta_rule(q, k, v, g, beta):
    c = q.shape[-2]
    tri_incl = jnp.tril(jnp.ones((c, c), bool))
    tri_strict = jnp.tril(jnp.ones((c, c), bool), -1)
    gc = jnp.cumsum(g, axis=-1)
    diff = gc[..., :, None] - gc[..., None, :]
    gamma = jnp.where(tri_incl, jnp.exp(jnp.where(tri_incl, diff, 0.0)), 0.0)
    k_beta = k * beta[..., None]
    v_beta = v * beta[..., None]
    a_strict = jnp.where(tri_strict, jnp.einsum('bhnid,bhnjd->bhnij', k_beta, k) * gamma, 0.0)
    m = a_strict + jnp.eye(c, dtype=jnp.float32)
    u = lax.linalg.triangular_solve(m, v_beta, left_side=True, lower=True, unit_diagonal=True)
    w = lax.linalg.triangular_solve(m, k_beta * jnp.exp(gc)[..., None], left_side=True,
                                    lower=True, unit_diagonal=True)
    attn = jnp.einsum('bhnid,bhnjd->bhnij', q, k) * gamma
    q_dec = q * jnp.exp(gc)[..., None]
    k_dec = k * jnp.exp(gc[..., -1:] - gc)[..., None]
    g_last = jnp.exp(gc[..., -1])

    def step(s, xs):
        attn_n, u_n, w_n, qd_n, kd_n, gl_n = xs
        v_new = u_n - jnp.einsum('bhik,bhkv->bhiv', w_n, s)
        o = jnp.einsum('bhik,bhkv->bhiv', qd_n, s) + jnp.einsum('bhij,bhjv->bhiv', attn_n, v_new)
        s = s * gl_n[..., None, None] + jnp.einsum('bhik,bhiv->bhkv', kd_n, v_new)
        return s, o

    bsz, h, _, _, dk = q.shape
    s0 = jnp.zeros((bsz, h, dk, v.shape[-1]), jnp.float32)
    xs = tuple(_chunk_first(t) for t in (attn, u, w, q_dec, k_dec, g_last))
    _, o = lax.scan(step, s0, xs)
    return jnp.moveaxis(o, 0, 2)


def chunk_gla(q, k, v, glog):
    c = q.shape[-2]
    tri = jnp.tril(jnp.ones((c, c), bool))
    bcum = jnp.cumsum(glog, axis=-2)
    q_dec = q * jnp.exp(bcum)
    attn = jnp.where(tri, jnp.einsum('bhnik,bhnjk->bhnij', q_dec, k * jnp.exp(-bcum)), 0.0)
    o_intra = jnp.einsum('bhnij,bhnjv->bhniv', attn, v)
    b_last = bcum[..., -1:, :]
    k_dec = k * jnp.exp(b_last - bcum)
    decay = jnp.exp(b_last[..., 0, :])

    def step(s, xs):
        qd, kd, vv, dl = xs
        o = jnp.einsum('bhik,bhkv->bhiv', qd, s)
        s = s * dl[..., :, None] + jnp.einsum('bhik,bhiv->bhkv', kd, vv)
        return s, o

    bsz, h, _, _, dk = q.shape
    s0 = jnp.zeros((bsz, h, dk, v.shape[-1]), jnp.float32)
    _, o_inter = lax.scan(step, s0, tuple(_chunk_first(t) for t in (q_dec, k_dec, v, decay)))
    return o_intra + jnp.moveaxis(o_inter, 0, 2)


def gated_deltanet(q, k, v, a, bgate, z, conv_w, a_log, dt_bias, norm_w):
    f32 = jnp.float32
    bsz, l, _ = q.shape
    hd = (bsz, l, DN_HEADS, DN_HEAD_DIM)
    qkv = jax.nn.silu(causal_depthwise_conv(jnp.concatenate([q, k, v], axis=-1), conv_w))
    q, k, v = _split(qkv, (DN_DIM, DN_DIM, DN_DIM))
    q = l2_norm(q.reshape(hd).astype(f32)) * DN_HEAD_DIM ** -0.5
    k = l2_norm(k.reshape(hd).astype(f32))
    v = v.reshape(hd).astype(f32)
    beta = jax.nn.sigmoid(bgate.astype(f32))
    g = -jnp.exp(a_log.astype(f32)) * jax.nn.softplus(a.astype(f32) + dt_bias.astype(f32))
    o = chunk_gated_delta_rule(to_chunks(q, DN_CHUNK), to_chunks(k, DN_CHUNK), to_chunks(v, DN_CHUNK),
                               to_chunks(g, DN_CHUNK), to_chunks(beta, DN_CHUNK))
    o = from_chunks(o, DN_CHUNK)
    o = rms_norm(o, norm_w) * jax.nn.silu(z.reshape(hd).astype(f32))
    return o.reshape(bsz, l, DN_DIM).astype(z.dtype)


def even_mixer(h, w_in, conv_w, sinks, a_log, dt_bias, dn_norm_w, w_out, rel_table):
    bsz, l, _ = h.shape
    qa, ka, va, qb, kb, vb, zb, bb, ab = _split(h @ w_in, EVEN_IN_SIZES)
    o_a = sliding_window_attention(qa.reshape(bsz, l, SWA_Q_HEADS, SWA_HEAD_DIM),
                                   ka.reshape(bsz, l, SWA_KV_HEADS, SWA_HEAD_DIM),
                                   va.reshape(bsz, l, SWA_KV_HEADS, SWA_HEAD_DIM), sinks, rel_table)
    o_b = gated_deltanet(qb, kb, vb, ab, bb, zb, conv_w, a_log, dt_bias, dn_norm_w)
    return jnp.concatenate([o_a.astype(h.dtype), o_b.astype(h.dtype)], axis=-1) @ w_out


def odd_mixer(h, w_in, w_gate_up, b_gate, norm_w, w_out):
    f32 = jnp.float32
    bsz, l, _ = h.shape
    dk = GLA_KEY_DIM // GLA_HEADS
    dv = GLA_VAL_DIM // GLA_HEADS
    q, k, v, g, gk_low = _split(h @ w_in, ODD_IN_SIZES)
    glog = jax.nn.log_sigmoid((gk_low @ w_gate_up + b_gate).astype(f32)) / GLA_GATE_NORM
    q = q.reshape(bsz, l, GLA_HEADS, dk).astype(f32) * dk ** -0.5
    k = k.reshape(bsz, l, GLA_HEADS, dk).astype(f32)
    v = v.reshape(bsz, l, GLA_HEADS, dv).astype(f32)
    glog = glog.reshape(bsz, l, GLA_HEADS, dk)
    o = chunk_gla(to_chunks(q, GLA_CHUNK), to_chunks(k, GLA_CHUNK), to_chunks(v, GLA_CHUNK),
                  to_chunks(glog, GLA_CHUNK))
    o = from_chunks(o, GLA_CHUNK)
    o = rms_norm(o, norm_w) * jax.nn.silu(g.reshape(bsz, l, GLA_HEADS, dv).astype(f32))
    return o.reshape(bsz, l, GLA_VAL_DIM).astype(h.dtype) @ w_out


def setup_inputs(seed: int = 0) -> dict:
    key = jax.random.key(seed)
    ks = jax.random.split(key, 24)
    f32 = jnp.float32

    def nrm(k, shape, fan_in):
        return jax.random.normal(k, shape, f32) * fan_in ** -0.5

    dt = jnp.exp(jax.random.uniform(ks[10], (N_EVEN, DN_HEADS), f32) * (math.log(0.1) - math.log(0.001))
                 + math.log(0.001))
    return {
        "x": jax.random.normal(ks[0], (BATCH, SEQ, D_MODEL), f32),
        "meta_tokens": jax.random.normal(ks[1], (N_META, D_MODEL), f32),
        "norm_w": 1.0 + 0.02 * jax.random.normal(ks[2], (DEPTH, 6, D_MODEL), f32),
        "ffn_w_gate": nrm(ks[3], (DEPTH, 2, D_MODEL, D_FF), D_MODEL),
        "ffn_w_up": nrm(ks[4], (DEPTH, 2, D_MODEL, D_FF), D_MODEL),
        "ffn_w_down": nrm(ks[5], (DEPTH, 2, D_FF, D_MODEL), D_FF),
        "rel_bias_table": 0.5 * jax.random.normal(ks[6], (REL_BUCKETS, SWA_Q_HEADS), f32),
        "even_w_in": nrm(ks[7], (N_EVEN, D_MODEL, EVEN_IN_DIM), D_MODEL),
        "even_conv_w": nrm(ks[8], (N_EVEN, DN_CONV, 3 * DN_DIM), DN_CONV),
        "swa_sinks": jax.random.normal(ks[9], (N_EVEN, SWA_Q_HEADS), f32),
        "dn_a_log": jnp.log(jax.random.uniform(ks[11], (N_EVEN, DN_HEADS), f32, 1.0, 16.0)),
        "dn_dt_bias": dt + jnp.log(-jnp.expm1(-dt)),
        "dn_norm_w": 1.0 + 0.02 * jax.random.normal(ks[12], (N_EVEN, DN_HEAD_DIM), f32),
        "even_w_out": nrm(ks[13], (N_EVEN, EVEN_MIX_DIM, D_MODEL), EVEN_MIX_DIM),
        "odd_w_in": nrm(ks[14], (N_ODD, D_MODEL, ODD_IN_DIM), D_MODEL),
        "gla_w_gate_up": nrm(ks[15], (N_ODD, GLA_GATE_RANK, GLA_KEY_DIM), GLA_GATE_RANK),
        "gla_b_gate": 0.1 * jax.random.normal(ks[16], (N_ODD, GLA_KEY_DIM), f32),
        "gla_norm_w": 1.0 + 0.02 * jax.random.normal(ks[17], (N_ODD, GLA_VAL_DIM // GLA_HEADS), f32),
        "odd_w_out": nrm(ks[18], (N_ODD, GLA_VAL_DIM, D_MODEL), GLA_VAL_DIM),
    }


def reference(x, meta_tokens, norm_w, ffn_w_gate, ffn_w_up, ffn_w_down, rel_bias_table,
              even_w_in, even_conv_w, swa_sinks, dn_a_log, dn_dt_bias, dn_norm_w, even_w_out,
              odd_w_in, gla_w_gate_up, gla_b_gate, gla_norm_w, odd_w_out):
    bsz = x.shape[0]
    meta = jnp.broadcast_to(meta_tokens[None].astype(x.dtype), (bsz, N_META, x.shape[-1]))
    h = jnp.concatenate([meta, x], axis=1)
    for layer in range(DEPTH):
        nw = norm_w[layer]
        f = swiglu(rms_norm(h, nw[0]), ffn_w_gate[layer, 0], ffn_w_up[layer, 0], ffn_w_down[layer, 0])
        h = h + 0.5 * rms_norm(f, nw[1])
        hn = rms_norm(h, nw[2])
        if layer % 2 == 0:
            i = layer // 2
            mix = even_mixer(hn, even_w_in[i], even_conv_w[i], swa_sinks[i], dn_a_log[i], dn_dt_bias[i],
                             dn_norm_w[i], even_w_out[i], rel_bias_table)
        else:
            i = layer // 2
            mix = odd_mixer(hn, odd_w_in[i], gla_w_gate_up[i], gla_b_gate[i], gla_norm_w[i], odd_w_out[i])
        h = h + rms_norm(mix, nw[3])
        f = swiglu(rms_norm(h, nw[4]), ffn_w_gate[layer, 1], ffn_w_up[layer, 1], ffn_w_down[layer, 1])
        h = h + 0.5 * rms_norm(f, nw[5])
    return h[:, N_META:]
```

```cpp
#include <hip/hip_runtime.h>
#include <cstdio>
#include <cstdint>
#ifndef MK_ONE_LAUNCH
#define MK_ONE_LAUNCH 1
#endif
namespace pg8 {
#define PG8_LAS __attribute__((address_space(3)))
typedef unsigned short bf16_t;
typedef short bf16x8 __attribute__((ext_vector_type(8)));
typedef float f32x4 __attribute__((ext_vector_type(4)));
typedef unsigned u32x4 __attribute__((ext_vector_type(4)));
constexpr int BM = 256, BK = 64, HALF = 128, HTB = HALF * BK * 2  , STAGE_BYTES = 8 * HTB, NXCD = 8, WGM = 8;

__host__ __device__ __forceinline__ int lds_byte(int r, int c) { const int st = (r >> 4) * 2 + (c >> 5), rr = r & 15, cc = c & 31, ob = rr * 64 + cc * 2; return st * 1024 + (ob ^ (((ob >> 9) & 1) << 5)); }
__host__ __device__ __forceinline__ void stage_rc(int b, int& R, int& C) { const int st = b / 1024, sb = b % 1024, swz = sb ^ (((sb >> 9) & 1) << 5); R = (st >> 1) * 16 + swz / 64; C = (st & 1) * 32 + (swz % 64) / 2; }
__host__ __device__ __forceinline__ int perm32(int rho) { const int n = rho >> 4, i = rho & 15; return 8 * (i >> 2) + 4 * n + (i & 3); }

struct Unit { int pm, pn; };
struct Gemm { const bf16_t* A; const bf16_t* Bt; int M, N, K; };

struct StaticOrder {
    int nM, nN, nwg, G, c;
    __host__ __device__ void init(int M, int N, int G_, int c_) { nM = M / BM; nN = N / BM; nwg = nM * nN; G = G_; c = c_; }
    __host__ __device__ bool next(int i, Unit& u) const {
        const long L = (long)i * G + c; if (L >= nwg) return false;
        int wgid = (int)L; { const int q = nwg / NXCD, r = nwg % NXCD, xcd = wgid % NXCD, off = wgid / NXCD; wgid = (xcd < r ? xcd * (q + 1) : r * (q + 1) + (xcd - r) * q) + off; }
        const int nig = WGM * nN, gid = wgid / nig, fm = gid * WGM, gsz = (nM - fm) < WGM ? (nM - fm) : WGM;
        u.pm = fm + ((wgid % nig) % gsz); u.pn = (wgid % nig) / gsz; return true;
    }
    __device__ __forceinline__ void a_ready(const Unit&) const {}
    __device__ __forceinline__ void done(const Unit&) const {}
};

__device__ __forceinline__ unsigned cvt_pk_bf16(float lo, float hi) { unsigned r; asm volatile("v_cvt_pk_bf16_f32 %0, %1, %2" : "=v"(r) : "v"(lo), "v"(hi)); return r; }
typedef float f32x2 __attribute__((ext_vector_type(2)));
__device__ __forceinline__ float fast_silu(float x) { return x * __builtin_amdgcn_rcpf(1.0f + __builtin_amdgcn_exp2f(-1.4426950408889634f * x)); }
struct EpiSwiGLU {
    static constexpr bool PERM = true, AFTER_DRAIN = false;
    bf16_t* O; int ldc;
    __device__ __forceinline__ void operator()(const f32x4 (&acc)[2][2][4][2], const Unit& u, int wr, int wc, int fr, int fq) const {
        const int row0 = u.pm * BM + wr * 64 + fr, col0 = u.pn * HALF + wc * 32 + 8 * fq;
#pragma unroll
        for (int ai = 0; ai < 2; ++ai)
#pragma unroll
            for (int m = 0; m < 4; ++m) {
                bf16_t* p = O + (size_t)(row0 + ai * HALF + m * 16) * ldc + col0;
                const f32x4 g0 = acc[ai][0][m][0], g1 = acc[ai][0][m][1], u0 = acc[ai][1][m][0], u1 = acc[ai][1][m][1];
                u32x4 w;
                w.x = cvt_pk_bf16(fast_silu(g0[0]) * u0[0], fast_silu(g0[1]) * u0[1]); w.y = cvt_pk_bf16(fast_silu(g0[2]) * u0[2], fast_silu(g0[3]) * u0[3]);
                w.z = cvt_pk_bf16(fast_silu(g1[0]) * u1[0], fast_silu(g1[1]) * u1[1]); w.w = cvt_pk_bf16(fast_silu(g1[2]) * u1[2], fast_silu(g1[3]) * u1[3]);
                *(u32x4*)p = w;
            }
    }
};
struct EpiF32 {
    static constexpr bool PERM = false, AFTER_DRAIN = false;
    float* O; int ldc;
    __device__ __forceinline__ void operator()(const f32x4 (&acc)[2][2][4][2], const Unit& u, int wr, int wc, int fr, int fq) const {
        const int row0 = u.pm * BM + wr * 64 + fr, col0 = u.pn * BM + wc * 32 + 4 * fq;
#pragma unroll
        for (int ai = 0; ai < 2; ++ai)
#pragma unroll
            for (int m = 0; m < 4; ++m) {
                float* p = O + (size_t)(row0 + ai * HALF + m * 16) * ldc + col0;
#pragma unroll
                for (int bj = 0; bj < 2; ++bj)
#pragma unroll
                    for (int n = 0; n < 2; ++n) *(f32x4*)(p + bj * HALF + n * 16) = acc[ai][bj][m][n];
            }
    }
};
struct EpiProj {
    static constexpr bool PERM = true, AFTER_DRAIN = false;
    bf16_t* O; int ldc; float* side; int side_pn;
    __device__ __forceinline__ void operator()(const f32x4 (&acc)[2][2][4][2], const Unit& u, int wr, int wc, int fr, int fq) const {
        const int row0 = u.pm * BM + wr * 64 + fr, col0 = u.pn * BM + wc * 32 + 8 * fq;
        if (u.pn == side_pn) {
            if (wc == 0 && fq < 2) {
#pragma unroll
                for (int ai = 0; ai < 2; ++ai)
#pragma unroll
                    for (int m = 0; m < 4; ++m) { float* p = side + (size_t)(row0 + ai * HALF + m * 16) * 16 + 8 * fq;
                        *(f32x4*)p = acc[ai][0][m][0]; *(f32x4*)(p + 4) = acc[ai][0][m][1]; }
            }
            return;
        }
#pragma unroll
        for (int ai = 0; ai < 2; ++ai)
#pragma unroll
            for (int m = 0; m < 4; ++m) { bf16_t* rowp = O + (size_t)(row0 + ai * HALF + m * 16) * ldc + col0;
#pragma unroll
                for (int bj = 0; bj < 2; ++bj) { const f32x4 v0 = acc[ai][bj][m][0], v1 = acc[ai][bj][m][1];
                    u32x4 w; w.x = cvt_pk_bf16(v0[0], v0[1]); w.y = cvt_pk_bf16(v0[2], v0[3]); w.z = cvt_pk_bf16(v1[0], v1[1]); w.w = cvt_pk_bf16(v1[2], v1[3]);
                    *(u32x4*)(rowp + bj * HALF) = w; } }
    }
};
template <class Epi, class Sched, bool ALIGN_EPI = false, bool SP2 = false>
__device__ __forceinline__ void gemm_phase(PG8_LAS unsigned char* lds, const Gemm g, const Sched& S, const Epi& E) {
    const int tid = threadIdx.x, wid = __builtin_amdgcn_readfirstlane(tid >> 6), lane = tid & 63, wr = wid >> 2, wc = wid & 3, fr = lane & 15, fq = lane >> 4;
    const int K = g.K, nt = K / BK;
    unsigned voffA[2], voffB[2];
#pragma unroll
    for (int i = 0; i < 2; ++i) { int R, C; stage_rc(tid * 16 + i * 8192, R, C); const int Rb = Epi::PERM ? ((R & ~31) + perm32(R & 31)) : R;
        voffA[i] = (unsigned)(R * K + C) * 2u; voffB[i] = (unsigned)(Rb * K + C) * 2u; }
    const size_t kstep = (size_t)(BK * 2);
    const size_t hstep = (size_t)HALF * K * 2;
    const size_t tstep = 2 * hstep;
    const unsigned ldsw = (unsigned)wid * 1024u;
    const int aoff = lds_byte(wr * 64 + fr, fq * 8), boff = lds_byte(wc * 32 + fr, fq * 8);
#define PG8_SA(b, h) (((b) * 2 + (h)) * HTB)
#define PG8_SB(b, h) ((4 + (b) * 2 + (h)) * HTB)
#define PG8_STAGE(bufoff, gbase, voff) do { _Pragma("unroll") for (int _i = 0; _i < 2; ++_i) \
        __builtin_amdgcn_global_load_lds((const unsigned*)((const char*)(gbase) + (voff)[_i]), (PG8_LAS unsigned*)(lds + (bufoff) + ldsw + _i * 8192), 16, 0, 0); } while (0)
#define PG8_LDA(dst, b, h) do { _Pragma("unroll") for (int m = 0; m < 4; ++m) _Pragma("unroll") for (int k = 0; k < 2; ++k) dst[m][k] = *(const PG8_LAS bf16x8*)(lds + PG8_SA(b, h) + aoff + m * 2048 + k * 1024); } while (0)
#define PG8_LDB(dst, b, h) do { _Pragma("unroll") for (int n = 0; n < 2; ++n) _Pragma("unroll") for (int k = 0; k < 2; ++k) dst[n][k] = *(const PG8_LAS bf16x8*)(lds + PG8_SB(b, h) + boff + n * 2048 + k * 1024); } while (0)
#define PG8_MMA(ai, bj, At, Bt) do { __builtin_amdgcn_s_setprio(1); _Pragma("unroll") for (int m = 0; m < 4; ++m) _Pragma("unroll") for (int n = 0; n < 2; ++n) _Pragma("unroll") for (int k = 0; k < 2; ++k) \
        acc[ai][bj][m][n] = __builtin_amdgcn_mfma_f32_16x16x32_bf16(Bt[n][k], At[m][k], acc[ai][bj][m][n], 0, 0, 0); __builtin_amdgcn_s_setprio(0); } while (0)
#define PG8_WAIT_V(n) asm volatile("s_waitcnt vmcnt(" #n ")" ::: "memory")
#define PG8_WAIT_L(n) asm volatile("s_waitcnt lgkmcnt(" #n ")" ::: "memory")
#define PG8_BAR __builtin_amdgcn_s_barrier()
#define PG8_SCHED __builtin_amdgcn_sched_barrier(0)
    Unit cur, nxt; int ui = 0;
    if (!S.next(0, cur)) return;
    f32x4 acc[2][2][4][2];
#pragma unroll
    for (int a = 0; a < 2; ++a)
#pragma unroll
        for (int b = 0; b < 2; ++b)
#pragma unroll
            for (int m = 0; m < 4; ++m)
#pragma unroll
                for (int n = 0; n < 2; ++n) acc[a][b][m][n] = (f32x4){0.f, 0.f, 0.f, 0.f};
    bf16x8 At[4][2], B0[2][2], B1[2][2];
    const char* cA = (const char*)g.A + (size_t)cur.pm * tstep; const char* cB = (const char*)g.Bt + (size_t)cur.pn * tstep;
    S.a_ready(cur);
    if constexpr (SP2) {
        PG8_STAGE(PG8_SB(0, 0), cB, voffB); PG8_STAGE(PG8_SB(0, 1), cB + hstep, voffB); PG8_STAGE(PG8_SA(0, 0), cA, voffA); PG8_STAGE(PG8_SA(0, 1), cA + hstep, voffA);
        if (wr == 1) PG8_BAR;
        PG8_WAIT_V(2); PG8_BAR;
        PG8_STAGE(PG8_SB(1, 0), cB + kstep, voffB); PG8_STAGE(PG8_SA(1, 0), cA + kstep, voffA); PG8_STAGE(PG8_SB(1, 1), cB + hstep + kstep, voffB);
        PG8_WAIT_V(6); PG8_BAR;
    } else {
        PG8_STAGE(PG8_SB(0, 0), cB, voffB); PG8_STAGE(PG8_SA(0, 0), cA, voffA); PG8_STAGE(PG8_SB(0, 1), cB + hstep, voffB); PG8_STAGE(PG8_SA(0, 1), cA + hstep, voffA);
        if (wr == 1) PG8_BAR;
        PG8_WAIT_V(4); PG8_BAR;
        PG8_STAGE(PG8_SB(1, 0), cB + kstep, voffB); PG8_STAGE(PG8_SA(1, 0), cA + kstep, voffA); PG8_STAGE(PG8_SB(1, 1), cB + hstep + kstep, voffB);
        PG8_WAIT_V(6); PG8_BAR;
    }
    for (;;) {
        const bool has_next = S.next(ui + 1, nxt);
        const char* nA = has_next ? (const char*)g.A + (size_t)nxt.pm * tstep : cA; const char* nB = has_next ? (const char*)g.Bt + (size_t)nxt.pn * tstep : cB;
        for (int t = 0; t < nt; t += 2) {
            const bool last = (t == nt - 2);
            const char* a1 = cA + (size_t)(t + 1) * kstep;
            const char* a2 = last ? nA : cA + (size_t)(t + 2) * kstep; const char* b2 = last ? nB : cB + (size_t)(t + 2) * kstep;
            const char* a3 = a2 + kstep; const char* b3 = b2 + kstep;
            if (last && has_next) S.a_ready(nxt);
            if constexpr (SP2) {
            PG8_LDB(B0, 0, 0); PG8_LDB(B1, 0, 1); PG8_SCHED; PG8_LDA(At, 0, 0); PG8_STAGE(PG8_SA(1, 1), a1 + hstep, voffA);
            PG8_WAIT_V(8); PG8_WAIT_L(0); PG8_BAR; PG8_MMA(0, 0, At, B0); PG8_MMA(0, 1, At, B1); PG8_BAR; PG8_SCHED;
            PG8_LDA(At, 0, 1); PG8_STAGE(PG8_SB(0, 0), b2, voffB); PG8_STAGE(PG8_SB(0, 1), b2 + hstep, voffB); PG8_STAGE(PG8_SA(0, 0), a2, voffA);
            PG8_WAIT_V(8); PG8_WAIT_L(0); PG8_BAR; PG8_MMA(1, 0, At, B0); PG8_MMA(1, 1, At, B1); PG8_BAR; PG8_SCHED;
            PG8_LDB(B0, 1, 0); PG8_LDB(B1, 1, 1); PG8_SCHED; PG8_LDA(At, 1, 0); PG8_STAGE(PG8_SA(0, 1), a2 + hstep, voffA);
            PG8_WAIT_V(8); PG8_WAIT_L(0); PG8_BAR; PG8_MMA(0, 0, At, B0); PG8_MMA(0, 1, At, B1); PG8_BAR; PG8_SCHED;
            PG8_LDA(At, 1, 1); PG8_STAGE(PG8_SB(1, 0), b3, voffB); PG8_STAGE(PG8_SB(1, 1), b3 + hstep, voffB); PG8_STAGE(PG8_SA(1, 0), a3, voffA);
            PG8_WAIT_V(8); PG8_WAIT_L(0); PG8_BAR; PG8_MMA(1, 0, At, B0); PG8_MMA(1, 1, At, B1); PG8_BAR; PG8_SCHED;
            } else {
            PG8_LDB(B0, 0, 0); PG8_SCHED; PG8_LDA(At, 0, 0); PG8_STAGE(PG8_SA(1, 1), a1 + hstep, voffA);
            PG8_WAIT_L(8); PG8_BAR; PG8_WAIT_L(0); PG8_MMA(0, 0, At, B0); PG8_BAR; PG8_SCHED;
            PG8_LDB(B1, 0, 1); PG8_STAGE(PG8_SB(0, 0), b2, voffB);
            PG8_BAR; PG8_WAIT_L(0); PG8_MMA(0, 1, At, B1); PG8_BAR;
            PG8_LDA(At, 0, 1); PG8_STAGE(PG8_SA(0, 0), a2, voffA);
            PG8_BAR; PG8_WAIT_L(0); PG8_MMA(1, 0, At, B0); PG8_BAR; PG8_SCHED;
            PG8_STAGE(PG8_SB(0, 1), b2 + hstep, voffB);
            PG8_WAIT_V(6); PG8_BAR; PG8_MMA(1, 1, At, B1); PG8_BAR;
            PG8_LDB(B0, 1, 0); PG8_SCHED; PG8_LDA(At, 1, 0); PG8_STAGE(PG8_SA(0, 1), a2 + hstep, voffA);
            PG8_WAIT_L(8); PG8_BAR; PG8_WAIT_L(0); PG8_MMA(0, 0, At, B0); PG8_BAR; PG8_SCHED;
            PG8_LDB(B1, 1, 1); PG8_STAGE(PG8_SB(1, 0), b3, voffB);
            PG8_BAR; PG8_WAIT_L(0); PG8_MMA(0, 1, At, B1); PG8_BAR;
            PG8_LDA(At, 1, 1); PG8_STAGE(PG8_SA(1, 0), a3, voffA);
            PG8_BAR; PG8_WAIT_L(0); PG8_MMA(1, 0, At, B0); PG8_BAR; PG8_SCHED;
            PG8_STAGE(PG8_SB(1, 1), b3 + hstep, voffB);
            PG8_WAIT_V(6); PG8_BAR; PG8_MMA(1, 1, At, B1); PG8_BAR;
            }
        }
        if constexpr (ALIGN_EPI) { if (wr == 0) PG8_BAR; }
        if constexpr (!Epi::AFTER_DRAIN) { E(acc, cur, wr, wc, fr, fq); S.done(cur); }
        if (!has_next) break;
#pragma unroll
        for (int a = 0; a < 2; ++a)
#pragma unroll
            for (int b = 0; b < 2; ++b)
#pragma unroll
                for (int m = 0; m < 4; ++m)
#pragma unroll
                    for (int n = 0; n < 2; ++n) acc[a][b][m][n] = (f32x4){0.f, 0.f, 0.f, 0.f};
        cur = nxt; cA = nA; cB = nB; ++ui;
        if constexpr (ALIGN_EPI) { if (wr == 1) PG8_BAR; }
    }
    PG8_WAIT_V(0);
    if constexpr (!ALIGN_EPI) { if (wr == 0) PG8_BAR; }
    PG8_BAR;
    if constexpr (Epi::AFTER_DRAIN) { E.fused(acc, cur, wr, wc, fr, fq, lds, wid, lane); S.done(cur); }
#undef PG8_SA
#undef PG8_SB
#undef PG8_STAGE
#undef PG8_LDA
#undef PG8_LDB
#undef PG8_MMA
#undef PG8_WAIT_V
#undef PG8_WAIT_L
#undef PG8_BAR
#undef PG8_SCHED
}
}
#define RLX_AGENT __ATOMIC_RELAXED, __HIP_MEMORY_SCOPE_AGENT
#define DI __device__ __forceinline__
#define LAS __attribute__((address_space(3)))
typedef unsigned short bf16;
typedef float f32x4 __attribute__((ext_vector_type(4)));
typedef float f32x2 __attribute__((ext_vector_type(2)));
typedef short bf16x8 __attribute__((ext_vector_type(8)));
typedef unsigned v4u __attribute__((ext_vector_type(4)));
typedef unsigned v2u __attribute__((ext_vector_type(2)));

constexpr int D = 1024, FF = 2816, NBATCH = 4, SEQ = 4096, NMETA = 16, LSEQ = SEQ + NMETA, MR = NBATCH * SEQ, RV = MR + NMETA, RT = 16640;
constexpr int NIN = 3072;
constexpr float EPS = 1e-6f;
constexpr int NWAVES = 8, NTHREADS = 512;
constexpr int N_PHASES = 25;

constexpr size_t MiB = 1u << 20;
constexpr size_t WS_CTL = 0, CTL_ZERO_BYTES = 1 * MiB;
constexpr size_t WS_HMETA = 1 * MiB;
constexpr size_t WS_GATES = 2 * MiB;
constexpr size_t WS_WGU_A = 4 * MiB, WS_WDN_A = 15 * MiB, WS_WGU_B = 21 * MiB, WS_WDN_B = 32 * MiB, WS_WIN = 38 * MiB, WS_WOUT = 44 * MiB;
constexpr size_t WS_HN = 46 * MiB;
constexpr size_t WS_BIG = 79 * MiB;
constexpr size_t WS_F = 177 * MiB;
constexpr size_t WS_WGK = 242 * MiB;
constexpr size_t WS_END = 243 * MiB;
static_assert(WS_HN + (size_t)RT * D * 2 <= WS_BIG && WS_BIG + (size_t)RT * NIN * 2 <= WS_F && WS_F + (size_t)RT * D * 4 <= WS_WGK, "d_ws map");

constexpr int RING_BYTES = 131072, LDSCTL_OFF = RING_BYTES, MISC_OFF = LDSCTL_OFF + 320, LDS_BYTES = 147456;

DI float bf2f(unsigned v) { return __uint_as_float(v << 16); }
DI unsigned f2bf(float f) { unsigned u = __float_as_uint(f); return (u + 0x7fffu + ((u >> 16) & 1u)) >> 16; }
DI unsigned pk2(float lo, float hi) { return f2bf(lo) | (f2bf(hi) << 16); }
DI float bflo(unsigned w) { return __uint_as_float(w << 16); }
DI float bfhi(unsigned w) { return __uint_as_float(w & 0xffff0000u); }
#define LDS_WAIT() asm volatile("s_waitcnt lgkmcnt(0)" ::: "memory")

DI float dpp_f(float x, int ctrl_unused) { return x; }
#define DPP_ADD(x, ctrl) ((x) + __int_as_float(__builtin_amdgcn_update_dpp(0, __float_as_int(x), (ctrl), 0xF, 0xF, true)))
DI float row16_sum(float v) { v = DPP_ADD(v, 0xB1); v = DPP_ADD(v, 0x4E); v = DPP_ADD(v, 0x141); v = DPP_ADD(v, 0x140); return v; }
DI float wave_sum(float v) {
    v = row16_sum(v);
    const int i = __float_as_int(v);
    return __int_as_float(__builtin_amdgcn_readlane(i, 0)) + __int_as_float(__builtin_amdgcn_readlane(i, 16)) + __int_as_float(__builtin_amdgcn_readlane(i, 32)) + __int_as_float(__builtin_amdgcn_readlane(i, 48));
}
DI float wave_max(float v) {
#pragma unroll
    for (int o = 1; o < 64; o <<= 1) v = fmaxf(v, __shfl_xor(v, o));
    return v;
}
DI float sigmoidf_(float x) { return 1.0f / (1.0f + __expf(-x)); }
DI float siluf_(float x) { return x / (1.0f + __expf(-x)); }
DI float softplusf_(float x) { return fmaxf(x, 0.f) + log1pf(__expf(-fabsf(x))); }
DI float logsigmoidf_(float x) { return fminf(x, 0.f) - log1pf(__expf(-fabsf(x))); }

struct Ctx {
    LAS unsigned char* lds;
    int tid, lane, wave, G, gw, NGW;
    const float* in[19];
    float* out; unsigned char* ws;
};
DI int pos_to_row(int b, int p) { return p < NMETA ? MR + p : b * SEQ + (p - NMETA); }
DI float* h_ptr(const Ctx& C, int r) { return r < MR ? C.out + (size_t)r * D : (float*)(C.ws + WS_HMETA) + (size_t)(r - MR) * D; }

struct SrcCol { const float* W; int N; int col; };
template <class Map>
DI void transpose_items(const Ctx& C, const Map mp, int K, int ND, bf16* WT) {
    LAS float* scr = (LAS float*)(C.lds + C.wave * 16384);
    const int lane = C.lane, ndb = ND / 32, items = (K / 64) * ndb;
    for (int it = C.gw; it < items; it += C.NGW) {
        const int kb = it / ndb, db = it % ndb, k0 = 64 * kb, d0 = 32 * db;
        const SrcCol sc = mp(d0 + (lane & 31));
#pragma unroll 8
        for (int i = 0; i < 32; ++i) { const int kk = 2 * i + (lane >> 5); scr[kk * 33 + (lane & 31)] = sc.col >= 0 ? sc.W[(size_t)(k0 + kk) * sc.N + sc.col] : 0.f; }
        LDS_WAIT(); asm volatile("" ::: "memory");
        const int c = lane & 7;
#pragma unroll
        for (int j = 0; j < 4; ++j) { const int n = (lane >> 3) + 8 * j; const LAS float* s = scr + (8 * c) * 33 + n;
            v4u o; o.x = pk2(s[0 * 33], s[1 * 33]); o.y = pk2(s[2 * 33], s[3 * 33]); o.z = pk2(s[4 * 33], s[5 * 33]); o.w = pk2(s[6 * 33], s[7 * 33]);
            *(v4u*)(WT + (size_t)(d0 + n) * K + k0 + 8 * c) = o; }
        LDS_WAIT(); asm volatile("" ::: "memory");
    }
}
struct MapIdent { const float* W; int N; int off; int nvalid; DI SrcCol operator()(int d) const { SrcCol s; s.W = W; s.N = N; s.col = d < nvalid ? off + d : -1; return s; } };
struct MapGateUp { const float* Wg; const float* Wu; DI SrcCol operator()(int d) const { const int t = d >> 8, w = d & 255; SrcCol s; s.N = FF;
    const unsigned long long dlt = (unsigned long long)(uintptr_t)Wu - (unsigned long long)(uintptr_t)Wg; s.W = (const float*)((uintptr_t)Wg + (w < 128 ? 0ull : dlt)); s.col = 128 * t + (w & 127); return s; } };

DI void convert_weights(const Ctx& C, int l) {
    unsigned char* ws = C.ws;
    const size_t wgu = (size_t)D * FF, wdn = (size_t)FF * D;
    const float* g0 = C.in[3] + (size_t)(l * 2 + 0) * wgu; const float* u0 = C.in[4] + (size_t)(l * 2 + 0) * wgu; const float* d0 = C.in[5] + (size_t)(l * 2 + 0) * wdn;
    const float* g1 = C.in[3] + (size_t)(l * 2 + 1) * wgu; const float* u1 = C.in[4] + (size_t)(l * 2 + 1) * wgu; const float* d1 = C.in[5] + (size_t)(l * 2 + 1) * wdn;
    transpose_items(C, MapGateUp{g0, u0}, D, 2 * FF, (bf16*)(ws + WS_WGU_A));
    transpose_items(C, MapIdent{d0, D, 0, D}, FF, D, (bf16*)(ws + WS_WDN_A));
    transpose_items(C, MapGateUp{g1, u1}, D, 2 * FF, (bf16*)(ws + WS_WGU_B));
    transpose_items(C, MapIdent{d1, D, 0, D}, FF, D, (bf16*)(ws + WS_WDN_B));
    if (l == 0) {
        transpose_items(C, MapIdent{C.in[7], 2824, 0, 2824}, D, NIN, (bf16*)(ws + WS_WIN));
        transpose_items(C, MapIdent{C.in[13], D, 0, D}, D, D, (bf16*)(ws + WS_WOUT));
    } else {
        transpose_items(C, MapIdent{C.in[14], 3088, 0, 3072}, D, NIN, (bf16*)(ws + WS_WIN));
        transpose_items(C, MapIdent{C.in[18], D, 0, D}, D, D, (bf16*)(ws + WS_WOUT));
        transpose_items(C, MapIdent{C.in[14], 3088, 3072, 16}, D, 32, (bf16*)(ws + WS_WGK));
    }
}

DI void rms_row_to_bf16(const float* src, const float* w, bf16* dst, int lane) {
    f32x4 v[4]; float ss = 0.f;
#pragma unroll
    for (int j = 0; j < 4; ++j) { v[j] = ((const f32x4*)src)[lane + 64 * j]; ss += (v[j].x * v[j].x + v[j].y * v[j].y) + (v[j].z * v[j].z + v[j].w * v[j].w); }
    const float rstd = rsqrtf(wave_sum(ss) * (1.0f / D) + EPS);
#pragma unroll
    for (int j = 0; j < 4; ++j) { const f32x4 wv = ((const f32x4*)w)[lane + 64 * j]; const f32x4 o = v[j] * rstd * wv;
        v2u pk; pk.x = pk2(o.x, o.y); pk.y = pk2(o.z, o.w); ((v2u*)dst)[lane + 64 * j] = pk; }
}

DI void ph_prologue(const Ctx& C) {
    convert_weights(C, 0);
    bf16* hn = (bf16*)(C.ws + WS_HN);
    const float* nw0 = C.in[2];
    for (int r = C.gw; r < RT; r += C.NGW) {
        bf16* o = hn + (size_t)r * D;
        if (r >= RV) {
#pragma unroll
            for (int j = 0; j < 4; ++j) ((v2u*)o)[C.lane + 64 * j] = (v2u){0u, 0u};
        } else {
            const float* src = r < MR ? C.in[0] + (size_t)r * D : C.in[1] + (size_t)(r - MR) * D;
            rms_row_to_bf16(src, nw0, o, C.lane);
        }
    }
    float* hm = (float*)(C.ws + WS_HMETA);
    for (int r = NMETA + C.gw; r < 256; r += C.NGW) {
#pragma unroll
        for (int j = 0; j < 4; ++j) ((f32x4*)(hm + (size_t)r * D))[C.lane + 64 * j] = (f32x4){0.f, 0.f, 0.f, 0.f};
    }
}

DI void ph_rownorm(const Ctx& C, int l, int which) {
    const float* nw = C.in[2] + (size_t)l * 6 * D;
    const float* wa = nw + (which == 0 ? 1 : which == 1 ? 3 : 5) * D;
    const float scale = which == 1 ? 1.0f : 0.5f;
    const float* wb = which == 0 ? nw + 2 * D : which == 1 ? nw + 4 * D : (l == 0 ? C.in[2] + 6 * D : (const float*)nullptr);
    const bool first = (l == 0 && which == 0);
    const float* F = (const float*)(C.ws + WS_F);
    bf16* hn = (bf16*)(C.ws + WS_HN);
    const int lane = C.lane;
    for (int r = C.gw; r < RV; r += C.NGW) {
        const float* fr = F + (size_t)r * D;
        float* hp = h_ptr(C, r);
        const float* base = first ? (r < MR ? C.in[0] + (size_t)r * D : C.in[1] + (size_t)(r - MR) * D) : (const float*)hp;
        f32x4 v[4], hb[4]; float ss = 0.f;
#pragma unroll
        for (int j = 0; j < 4; ++j) { v[j] = ((const f32x4*)fr)[lane + 64 * j]; hb[j] = ((const f32x4*)base)[lane + 64 * j]; ss += (v[j].x * v[j].x + v[j].y * v[j].y) + (v[j].z * v[j].z + v[j].w * v[j].w); }
        const float rstd = rsqrtf(wave_sum(ss) * (1.0f / D) + EPS) * scale;
        float s2 = 0.f;
#pragma unroll
        for (int j = 0; j < 4; ++j) { const f32x4 wv = ((const f32x4*)wa)[lane + 64 * j]; hb[j] = hb[j] + v[j] * rstd * wv;
            ((f32x4*)hp)[lane + 64 * j] = hb[j]; s2 += (hb[j].x * hb[j].x + hb[j].y * hb[j].y) + (hb[j].z * hb[j].z + hb[j].w * hb[j].w); }
        if (wb) {
            const float r2 = rsqrtf(wave_sum(s2) * (1.0f / D) + EPS);
            bf16* o = hn + (size_t)r * D;
#pragma unroll
            for (int j = 0; j < 4; ++j) { const f32x4 wv = ((const f32x4*)wb)[lane + 64 * j]; const f32x4 y = hb[j] * r2 * wv;
                v2u pk; pk.x = pk2(y.x, y.y); pk.y = pk2(y.z, y.w); ((v2u*)o)[lane + 64 * j] = pk; }
        }
    }
}
#define XB_TMO      128
#define XB_XCNT(j)  (256  + 64 * (j))
#define XB_XSUB(j)  (1280 + 64 * (j))
#define XB_XGEN(j)  (2304 + 64 * (j))
#define XB_TOP      3328
#define XB_TOPGEN   3392
#define XCD_BAR_WORDS 3456
#define XB_SPIN_CAP (1u << 18)

__device__ __forceinline__ unsigned xb_ld(unsigned* p)              { return __hip_atomic_load(p, __ATOMIC_RELAXED, __HIP_MEMORY_SCOPE_AGENT); }
__device__ __forceinline__ unsigned xb_add(unsigned* p, unsigned v) { return __hip_atomic_fetch_add(p, v, __ATOMIC_RELAXED, __HIP_MEMORY_SCOPE_AGENT); }
__device__ __forceinline__ unsigned xb_xcc_id() { return (unsigned)__builtin_amdgcn_s_getreg((3 << 11) | 20) & 0xFu; }
#define XB_SPIN(cond, bar) do { unsigned _sp = 0; while (cond) { __builtin_amdgcn_s_sleep(1); \
    if ((++_sp & 255u) == 0u) { if (xb_ld(&(bar)[XB_TMO])) break; if (_sp > XB_SPIN_CAP) { atomicAdd(&(bar)[XB_TMO], 1u); break; } } } } while (0)

struct XcdBarrier {
    unsigned* bar; unsigned x;
    volatile LAS unsigned* st;
};

__device__ __forceinline__ XcdBarrier xcd_barrier_post(unsigned* bar, volatile LAS unsigned* st) {
    XcdBarrier b; b.bar = bar; b.x = xb_xcc_id(); b.st = st;
    if (threadIdx.x == 0) (void)xb_add(&bar[XB_XCNT(b.x)], 1u);
    return b;
}
__device__ __forceinline__ void xcd_barrier_complete(unsigned* bar, unsigned x, unsigned& nloc, unsigned& nx) {
    const unsigned G = gridDim.x * gridDim.y * gridDim.z;
    unsigned sum, cnt, mine, sp = 0u;
    for (;;) {
        sum = 0u; cnt = 0u; mine = 0u;
#pragma unroll
        for (unsigned j = 0; j < 16; ++j) { const unsigned c = xb_ld(&bar[XB_XCNT(j)]); sum += c; cnt += (c > 0u) ? 1u : 0u; mine = (j == x) ? c : mine; }
        if (sum == G) break;
        __builtin_amdgcn_s_sleep(1);
        if ((++sp & 255u) == 0u) { if (xb_ld(&bar[XB_TMO])) break; if (sp > XB_SPIN_CAP) { atomicAdd(&bar[XB_TMO], 1u); break; } }
    }
    nloc = mine > 0u ? mine : 1u; nx = cnt > 0u ? cnt : 1u;
}

__device__ __forceinline__ void xcd_barrier(const XcdBarrier& b) {
    asm volatile("s_waitcnt vmcnt(0)" ::: "memory");
    __syncthreads();
    if (threadIdx.x == 0) {
        unsigned* bar = b.bar;
        __builtin_amdgcn_s_waitcnt(0);
        unsigned nloc = b.st[0], nx = b.st[1];
        if (nloc == 0u) { xcd_barrier_complete(bar, b.x, nloc, nx); b.st[0] = nloc; b.st[1] = nx; }
        const unsigned old = xb_add(&bar[XB_XSUB(b.x)], 1u);
        const unsigned gen = old / nloc;
        if (old + 1u == (gen + 1u) * nloc) {
            __builtin_amdgcn_fence(__ATOMIC_RELEASE, "agent");
            asm volatile("s_waitcnt vmcnt(0)" ::: "memory");
            const unsigned og = xb_add(&bar[XB_TOP], 1u);
            const unsigned tg = og / nx;
            if (og + 1u == (tg + 1u) * nx) xb_add(&bar[XB_TOPGEN], 1u);
            else XB_SPIN(xb_ld(&bar[XB_TOPGEN]) == tg, bar);
            __builtin_amdgcn_fence(__ATOMIC_ACQUIRE, "agent");
            xb_add(&bar[XB_XGEN(b.x)], 1u);
            asm volatile("s_waitcnt vmcnt(0)" ::: "memory");
        } else {
            XB_SPIN(xb_ld(&bar[XB_XGEN(b.x)]) == gen, bar);
            __builtin_amdgcn_fence(__ATOMIC_ACQUIRE, "agent");
            asm volatile("s_waitcnt vmcnt(0)" ::: "memory");
        }
    }
    __syncthreads();
}
DI void ph_dn_prep(const Ctx& C) {
    const bf16* proj = (const bf16*)(C.ws + WS_BIG);
    bf16* qkv = (bf16*)(C.ws + WS_F);
    float* gates = (float*)(C.ws + WS_GATES);
    const float* convw = C.in[8];
    const int lane = C.lane;
    for (int r = C.gw; r < RV; r += C.NGW) {
        int b, p; if (r < MR) { b = r >> 12; p = NMETA + (r & (SEQ - 1)); } else { b = 0; p = r - MR; }
#pragma unroll
        for (int s = 0; s < 3; ++s) {
            const int c0 = 512 * s + 8 * lane;
            float y[8];
#pragma unroll
            for (int e = 0; e < 8; ++e) y[e] = 0.f;
#pragma unroll
            for (int j = 0; j < 4; ++j) {
                const int pp = p - 3 + j;
                if (pp >= 0) {
                    const int rr = pos_to_row(b, pp);
                    const bf16x8 xv = *(const bf16x8*)(proj + (size_t)rr * NIN + 768 + c0);
                    const f32x4 w0 = *(const f32x4*)(convw + j * 1536 + c0), w1 = *(const f32x4*)(convw + j * 1536 + c0 + 4);
                    y[0] += w0.x * bf2f((unsigned short)xv[0]); y[1] += w0.y * bf2f((unsigned short)xv[1]); y[2] += w0.z * bf2f((unsigned short)xv[2]); y[3] += w0.w * bf2f((unsigned short)xv[3]);
                    y[4] += w1.x * bf2f((unsigned short)xv[4]); y[5] += w1.y * bf2f((unsigned short)xv[5]); y[6] += w1.z * bf2f((unsigned short)xv[6]); y[7] += w1.w * bf2f((unsigned short)xv[7]);
                }
            }
            float ss = 0.f;
#pragma unroll
            for (int e = 0; e < 8; ++e) { y[e] = siluf_(y[e]); ss += y[e] * y[e]; }
            if (s < 2) {
                ss = row16_sum(ss);
                const float sc = rsqrtf(ss + 1e-6f) * (s == 0 ? 0.08838834764831845f : 1.0f);
#pragma unroll
                for (int e = 0; e < 8; ++e) y[e] *= sc;
            }
            v4u o; o.x = pk2(y[0], y[1]); o.y = pk2(y[2], y[3]); o.z = pk2(y[4], y[5]); o.w = pk2(y[6], y[7]);
            *(v4u*)(qkv + (size_t)r * 1536 + c0) = o;
        }
        if (lane < 4) gates[(size_t)r * 16 + 8 + lane] = sigmoidf_(gates[(size_t)r * 16 + lane]);
        else if (lane < 8) { const int h = lane - 4; const float a = gates[(size_t)r * 16 + 4 + h];
            gates[(size_t)r * 16 + 12 + h] = -__expf(C.in[10][h]) * softplusf_(a + C.in[11][h]); }
    }
}

DI int t5_bucket(int n) { if (n < 16) return n; const int v = 16 + (int)(logf((float)n * 0.0625f) * (16.0f / 2.0794415416798357f)); return v < 31 ? v : 31; }

DI float swa_dot(const bf16x8 (&q)[8], const bf16* krow) {
    float s = 0.f;
#pragma unroll
    for (int i = 0; i < 8; ++i) { const bf16x8 kv = *(const bf16x8*)(krow + 8 * i);
#pragma unroll
        for (int e = 0; e < 8; ++e) s += bf2f((unsigned short)q[i][e]) * bf2f((unsigned short)kv[e]); }
    return s;
}
DI void ph_swa_naive(const Ctx& C) {
    const bf16* proj = (const bf16*)(C.ws + WS_BIG);
    bf16* mix = (bf16*)(C.ws + WS_HN);
    const float* table = C.in[6]; const float* sinks = C.in[9];
    const int lane = C.lane;
    const float NEG = -1e30f;
    for (int job = C.gw; job < RV * 8; job += C.NGW) {
        const int r = job >> 3, hq = job & 7, kvh = hq >> 2;
        int b, p; if (r < MR) { b = r >> 12; p = NMETA + (r & (SEQ - 1)); } else { b = 0; p = r - MR; }
        bf16x8 q[8];
#pragma unroll
        for (int i = 0; i < 8; ++i) q[i] = *(const bf16x8*)(proj + (size_t)r * NIN + hq * 64 + 8 * i);
        const int koff = 512 + kvh * 64, voff = 640 + kvh * 64;
        float s0 = NEG, s1 = NEG, s2 = NEG;
        if (p >= NMETA) {
            int pk = p - lane;
            if (pk >= NMETA) s0 = swa_dot(q, proj + (size_t)(b * SEQ + pk - NMETA) * NIN + koff) * 0.125f + table[t5_bucket(lane) * 8 + hq];
            pk = p - 64 - lane;
            if (pk >= NMETA) s1 = swa_dot(q, proj + (size_t)(b * SEQ + pk - NMETA) * NIN + koff) * 0.125f + table[t5_bucket(64 + lane) * 8 + hq];
            if (lane < NMETA) s2 = swa_dot(q, proj + (size_t)(MR + lane) * NIN + koff) * 0.125f + table[t5_bucket(p - lane) * 8 + hq];
        } else {
            if (lane <= p) s2 = swa_dot(q, proj + (size_t)(MR + lane) * NIN + koff) * 0.125f + table[t5_bucket(p - lane) * 8 + hq];
        }
        const float sink = sinks[hq];
        const float mx = fmaxf(wave_max(fmaxf(fmaxf(s0, s1), s2)), sink);
        const float e0 = s0 > -1e29f ? __expf(s0 - mx) : 0.f, e1 = s1 > -1e29f ? __expf(s1 - mx) : 0.f, e2 = s2 > -1e29f ? __expf(s2 - mx) : 0.f;
        const float den = wave_sum(e0 + e1 + e2) + __expf(sink - mx);
        float o = 0.f;
        if (p >= NMETA) {
            const int n0 = (p - NMETA + 1) < 64 ? (p - NMETA + 1) : 64;
            for (int j = 0; j < n0; ++j) { const float pj = __int_as_float(__builtin_amdgcn_readlane(__float_as_int(e0), j));
                o += pj * bf2f(proj[(size_t)(b * SEQ + p - j - NMETA) * NIN + voff + lane]); }
            const int n1 = (p - 64 - NMETA + 1) < 0 ? 0 : ((p - 64 - NMETA + 1) < 64 ? (p - 64 - NMETA + 1) : 64);
            for (int j = 0; j < n1; ++j) { const float pj = __int_as_float(__builtin_amdgcn_readlane(__float_as_int(e1), j));
                o += pj * bf2f(proj[(size_t)(b * SEQ + p - 64 - j - NMETA) * NIN + voff + lane]); }
        }
        const int nm = p >= NMETA ? NMETA : p + 1;
        for (int j = 0; j < nm; ++j) { const float pj = __int_as_float(__builtin_amdgcn_readlane(__float_as_int(e2), j));
            o += pj * bf2f(proj[(size_t)(MR + j) * NIN + voff + lane]); }
        mix[(size_t)r * D + hq * 64 + lane] = (bf16)f2bf(o / den);
    }
}

DI void ph_dn_scan_naive(const Ctx& C) {
    const bf16* qkv = (const bf16*)(C.ws + WS_F);
    bf16* oraw = (bf16*)(C.ws + WS_F + (size_t)RT * 1536 * 2);
    const float* gates = (const float*)(C.ws + WS_GATES);
    const int lane = C.lane;
    for (int job = C.gw; job < NBATCH * 4 * 128; job += C.NGW) {
        const int b = job >> 9, h = (job >> 7) & 3, v = job & 127;
        float s0 = 0.f, s1 = 0.f;
        for (int p = 0; p < LSEQ; ++p) {
            const int row = pos_to_row(b, p);
            const bf16* base = qkv + (size_t)row * 1536 + h * 128;
            const unsigned qq = *(const unsigned*)(base + 2 * lane), kk = *(const unsigned*)(base + 512 + 2 * lane);
            const float vv = bf2f(base[1024 + v]);
            const float g = gates[(size_t)row * 16 + 12 + h], beta = gates[(size_t)row * 16 + 8 + h];
            const float a = __expf(g);
            const float q0 = bflo(qq), q1 = bfhi(qq), k0 = bflo(kk), k1 = bfhi(kk);
            const float dks = wave_sum(k0 * s0 + k1 * s1), dqs = wave_sum(q0 * s0 + q1 * s1), dqk = wave_sum(q0 * k0 + q1 * k1);
            const float t = beta * (vv - a * dks);
            s0 = a * s0 + k0 * t; s1 = a * s1 + k1 * t;
            const float o = a * dqs + dqk * t;
            if (lane == 0 && (p >= NMETA || b == 0)) oraw[(size_t)row * 512 + h * 128 + v] = (bf16)f2bf(o);
        }
    }
}

DI void ph_dn_gate(const Ctx& C) {
    const bf16* proj = (const bf16*)(C.ws + WS_BIG);
    const bf16* oraw = (const bf16*)(C.ws + WS_F + (size_t)RT * 1536 * 2);
    bf16* mix = (bf16*)(C.ws + WS_HN);
    const float* nw = C.in[12];
    const int lane = C.lane;
    for (int r = C.gw; r < RV; r += C.NGW) {
        const int c0 = 8 * lane;
        const bf16x8 ov = *(const bf16x8*)(oraw + (size_t)r * 512 + c0), zv = *(const bf16x8*)(proj + (size_t)r * NIN + 2304 + c0);
        float o[8]; float ss = 0.f;
#pragma unroll
        for (int e = 0; e < 8; ++e) { o[e] = bf2f((unsigned short)ov[e]); ss += o[e] * o[e]; }
        const float rstd = rsqrtf(row16_sum(ss) * (1.0f / 128.0f) + EPS);
        const f32x4 w0 = *(const f32x4*)(nw + (c0 & 127)), w1 = *(const f32x4*)(nw + (c0 & 127) + 4);
        const float wv[8] = {w0.x, w0.y, w0.z, w0.w, w1.x, w1.y, w1.z, w1.w};
        float y[8];
#pragma unroll
        for (int e = 0; e < 8; ++e) y[e] = o[e] * rstd * wv[e] * siluf_(bf2f((unsigned short)zv[e]));
        v4u pk; pk.x = pk2(y[0], y[1]); pk.y = pk2(y[2], y[3]); pk.z = pk2(y[4], y[5]); pk.w = pk2(y[6], y[7]);
        *(v4u*)(mix + (size_t)r * D + 512 + c0) = pk;
    }
}

DI void ph_gla_prep(const Ctx& C) {
    const bf16* hn = (const bf16*)(C.ws + WS_HN);
    const bf16* wgk = (const bf16*)(C.ws + WS_WGK);
    float* glog = (float*)(C.ws + WS_F);
    const float* wup = C.in[15]; const float* bg = C.in[16];
    LAS float* sc = (LAS float*)(C.lds + C.wave * 16384);
    const int lane = C.lane, fr = lane & 15, fq = lane >> 4;
    for (int tile = C.gw; tile < RV / 16; tile += C.NGW) {
        const int r0 = tile * 16;
        f32x4 acc = {0.f, 0.f, 0.f, 0.f};
#pragma unroll 4
        for (int kk = 0; kk < 32; ++kk) {
            const bf16x8 a = *(const bf16x8*)(hn + (size_t)(r0 + fr) * D + kk * 32 + 8 * fq);
            const bf16x8 bb = *(const bf16x8*)(wgk + (size_t)fr * D + kk * 32 + 8 * fq);
            acc = __builtin_amdgcn_mfma_f32_16x16x32_bf16(a, bb, acc, 0, 0, 0);
        }
#pragma unroll
        for (int i = 0; i < 4; ++i) sc[(4 * fq + i) * 16 + fr] = acc[i];
        LDS_WAIT(); asm volatile("" ::: "memory");
        const int c0 = 8 * lane;
        const f32x4 b0 = *(const f32x4*)(bg + c0), b1 = *(const f32x4*)(bg + c0 + 4);
        for (int row = 0; row < 16; ++row) {
            f32x4 a0 = b0, a1 = b1;
#pragma unroll
            for (int j = 0; j < 16; ++j) { const float gk = sc[row * 16 + j];
                a0 += gk * *(const f32x4*)(wup + j * 512 + c0); a1 += gk * *(const f32x4*)(wup + j * 512 + c0 + 4); }
            f32x4 o0, o1;
            o0.x = logsigmoidf_(a0.x) * 0.0625f; o0.y = logsigmoidf_(a0.y) * 0.0625f; o0.z = logsigmoidf_(a0.z) * 0.0625f; o0.w = logsigmoidf_(a0.w) * 0.0625f;
            o1.x = logsigmoidf_(a1.x) * 0.0625f; o1.y = logsigmoidf_(a1.y) * 0.0625f; o1.z = logsigmoidf_(a1.z) * 0.0625f; o1.w = logsigmoidf_(a1.w) * 0.0625f;
            *(f32x4*)(glog + (size_t)(r0 + row) * 512 + c0) = o0; *(f32x4*)(glog + (size_t)(r0 + row) * 512 + c0 + 4) = o1;
        }
        LDS_WAIT(); asm volatile("" ::: "memory");
    }
}

DI void ph_gla_scan_naive(const Ctx& C) {
    const bf16* proj = (const bf16*)(C.ws + WS_BIG);
    const float* glog = (const float*)(C.ws + WS_F);
    bf16* oraw = (bf16*)(C.ws + WS_F + (size_t)RT * 512 * 4);
    const int lane = C.lane;
    for (int job = C.gw; job < NBATCH * 4 * 256; job += C.NGW) {
        const int b = job >> 10, h = (job >> 8) & 3, v = job & 255;
        float s0 = 0.f, s1 = 0.f;
        for (int p = 0; p < LSEQ; ++p) {
            const int row = pos_to_row(b, p);
            const bf16* base = proj + (size_t)row * NIN;
            const unsigned qq = *(const unsigned*)(base + h * 128 + 2 * lane), kk = *(const unsigned*)(base + 512 + h * 128 + 2 * lane);
            const float vv = bf2f(base[1024 + h * 256 + v]);
            const f32x2 gl = *(const f32x2*)(glog + (size_t)row * 512 + h * 128 + 2 * lane);
            s0 = __expf(gl.x) * s0 + bflo(kk) * vv; s1 = __expf(gl.y) * s1 + bfhi(kk) * vv;
            const float o = wave_sum(bflo(qq) * s0 + bfhi(qq) * s1) * 0.08838834764831845f;
            if (lane == 0 && (p >= NMETA || b == 0)) oraw[(size_t)row * D + h * 256 + v] = (bf16)f2bf(o);
        }
    }
}

DI void ph_gla_gate(const Ctx& C) {
    const bf16* proj = (const bf16*)(C.ws + WS_BIG);
    const bf16* oraw = (const bf16*)(C.ws + WS_F + (size_t)RT * 512 * 4);
    bf16* mix = (bf16*)(C.ws + WS_HN);
    const float* nw = C.in[17];
    const int lane = C.lane;
    for (int r = C.gw; r < RV; r += C.NGW) {
#pragma unroll
        for (int s = 0; s < 2; ++s) {
            const int c0 = 512 * s + 8 * lane;
            const bf16x8 ov = *(const bf16x8*)(oraw + (size_t)r * D + c0), gv = *(const bf16x8*)(proj + (size_t)r * NIN + 2048 + c0);
            float o[8]; float ss = 0.f;
#pragma unroll
            for (int e = 0; e < 8; ++e) { o[e] = bf2f((unsigned short)ov[e]); ss += o[e] * o[e]; }
            ss = row16_sum(ss); ss += __shfl_xor(ss, 16);
            const float rstd = rsqrtf(ss * (1.0f / 256.0f) + EPS);
            const f32x4 w0 = *(const f32x4*)(nw + (c0 & 255)), w1 = *(const f32x4*)(nw + (c0 & 255) + 4);
            const float wv[8] = {w0.x, w0.y, w0.z, w0.w, w1.x, w1.y, w1.z, w1.w};
            float y[8];
#pragma unroll
            for (int e = 0; e < 8; ++e) y[e] = o[e] * rstd * wv[e] * siluf_(bf2f((unsigned short)gv[e]));
            v4u pk; pk.x = pk2(y[0], y[1]); pk.y = pk2(y[2], y[3]); pk.z = pk2(y[4], y[5]); pk.w = pk2(y[6], y[7]);
            *(v4u*)(mix + (size_t)r * D + c0) = pk;
        }
    }
}
typedef float f32x16 __attribute__((ext_vector_type(16)));
typedef float f32x2_t __attribute__((ext_vector_type(2)));
typedef __bf16 bf16x2_t __attribute__((ext_vector_type(2)));
typedef short s16x4 __attribute__((ext_vector_type(4)));
DI int crow(int r, int h) { return (r & 3) + 8 * (r >> 2) + 4 * h; }
DI unsigned cvtpk(float lo, float hi) { f32x2_t v = {lo, hi}; bf16x2_t b = __builtin_convertvector(v, bf16x2_t); return __builtin_bit_cast(unsigned, b); }
template <int S_> DI bf16x8 pack8(const f32x16& x) {
    v4u p; p.x = cvtpk(x[8 * S_], x[8 * S_ + 1]); p.y = cvtpk(x[8 * S_ + 2], x[8 * S_ + 3]); p.z = cvtpk(x[8 * S_ + 4], x[8 * S_ + 5]); p.w = cvtpk(x[8 * S_ + 6], x[8 * S_ + 7]);
    return __builtin_bit_cast(bf16x8, p);
}
#define MFMA32(a, b, c) __builtin_amdgcn_mfma_f32_32x32x16_bf16((a), (b), (c), 0, 0, 0)
DI bf16x8 ld_perm(const bf16* p) { const v2u a = *(const v2u*)p, b = *(const v2u*)(p + 8); v4u w; w.x = a.x; w.y = a.y; w.z = b.x; w.w = b.y; return __builtin_bit_cast(bf16x8, w); }

constexpr size_t WS_C0 = 243 * MiB;
constexpr size_t WS_C0Q = WS_C0 + 384 * 1024;
constexpr size_t WS_DECAY = 244 * MiB;
constexpr size_t WS_END2 = 245 * MiB;
constexpr int N_CHUNKHEADS = 4 + NBATCH * 64 * 4;
DI int chunkhead_id(int b, int n, int h) { return n == 0 ? h : 4 + ((b * 64 + n - 1) * 4 + h); }

DI void ph_gla_chunk_prep(const Ctx& C) {
    bf16* proj = (bf16*)(C.ws + WS_BIG);
    const float* glog = (const float*)(C.ws + WS_F);
    bf16* attn_all = (bf16*)(C.ws + WS_HN);
    float* decay_all = (float*)(C.ws + WS_DECAY);
    LAS bf16* QD = (LAS bf16*)(C.lds); LAS bf16* KN = (LAS bf16*)(C.lds + 17408); LAS bf16* KDT = (LAS bf16*)(C.lds + 34816); LAS bf16* VT = (LAS bf16*)(C.lds + 53248);
    LAS float* GS = (LAS float*)(C.lds + 90112);
    const int t = C.tid, lane = C.lane, wave = C.wave;
    for (int job = blockIdx.x; job < N_CHUNKHEADS; job += C.G) {
        int b, n, h; if (job < 4) { b = 0; n = 0; h = job; } else { const int x = job - 4; h = x & 3; n = ((x >> 2) & 63) + 1; b = x >> 8; }
        const int in_row0 = n == 0 ? MR - 48 : b * SEQ + 64 * (n - 1), vfrom = n == 0 ? 48 : 0;
        const bf16* inb = proj + (size_t)in_row0 * NIN;
        bf16* ob = n == 0 ? (bf16*)(C.ws + WS_C0) : proj + (size_t)in_row0 * NIN;
        const float* gb = glog + (size_t)in_row0 * 512 + h * 128;
        const int c = t & 127, rg = t >> 7;
        float g[16]; float ls = 0.f;
#pragma unroll
        for (int rr = 0; rr < 16; ++rr) { const int i = 16 * rg + rr; g[rr] = i >= vfrom ? gb[(size_t)i * 512 + c] : 0.f; ls += g[rr]; }
        GS[rg * 128 + c] = ls;
#pragma unroll
        for (int q = 0; q < 4; ++q) { const int p = t + 512 * q, row = p >> 5, c8 = (p & 31) * 8;
            bf16x8 v = {0, 0, 0, 0, 0, 0, 0, 0}; if (row >= vfrom) v = *(const bf16x8*)(inb + (size_t)row * NIN + 1024 + h * 256 + c8);
#pragma unroll
            for (int e = 0; e < 8; ++e) VT[(c8 + e) * 72 + row] = (bf16)v[e]; }
        __syncthreads();
        float pre = 0.f, tot = 0.f;
#pragma unroll
        for (int gq = 0; gq < 4; ++gq) { const float x = GS[gq * 128 + c]; tot += x; if (gq < rg) pre += x; }
        float run = pre;
#pragma unroll
        for (int rr = 0; rr < 16; ++rr) { const int i = 16 * rg + rr; run += g[rr];
            float qv = 0.f, kv = 0.f; if (i >= vfrom) { qv = bf2f(inb[(size_t)i * NIN + h * 128 + c]); kv = bf2f(inb[(size_t)i * NIN + 512 + h * 128 + c]); }
            QD[i * 136 + c] = (bf16)f2bf(qv * __expf(run) * 0.08838834764831845f);
            KN[i * 136 + c] = (bf16)f2bf(kv * __expf(-run));
            KDT[c * 72 + i] = (bf16)f2bf(kv * __expf(tot - run)); }
        if (rg == 0) decay_all[(size_t)job * 128 + c] = __expf(tot);
        __syncthreads();
#pragma unroll
        for (int q = 0; q < 2; ++q) { const int p = t + 512 * q;
            { const int row = p >> 4, c8 = (p & 15) * 8; *(v4u*)(ob + (size_t)row * NIN + h * 128 + c8) = *(const LAS v4u*)(QD + row * 136 + c8); }
            { const int dk = p >> 3, i8 = (p & 7) * 8; *(v4u*)(ob + (size_t)(dk >> 1) * NIN + 512 + h * 128 + (dk & 1) * 64 + i8) = *(const LAS v4u*)(KDT + dk * 72 + i8); } }
#pragma unroll
        for (int q = 0; q < 4; ++q) { const int p = t + 512 * q, dv = p >> 3, i8 = (p & 7) * 8;
            *(v4u*)(ob + (size_t)(dv >> 2) * NIN + 1024 + h * 256 + (dv & 3) * 64 + i8) = *(const LAS v4u*)(VT + dv * 72 + i8); }
        if (wave < 4) {
            const int ti = wave >> 1, tj = wave & 1, l31 = lane & 31, hh = lane >> 5;
            f32x16 acc;
#pragma unroll
            for (int r = 0; r < 16; ++r) acc[r] = 0.f;
            if (tj <= ti) {
#pragma unroll
                for (int s = 0; s < 8; ++s) { const bf16x8 a = *(const LAS bf16x8*)(QD + (32 * ti + l31) * 136 + 16 * s + 8 * hh), bb = *(const LAS bf16x8*)(KN + (32 * tj + l31) * 136 + 16 * s + 8 * hh);
                    acc = MFMA32(a, bb, acc); }
            }
            bf16* ao = attn_all + (size_t)job * 4096;
#pragma unroll
            for (int r = 0; r < 16; ++r) { const int i = 32 * ti + crow(r, hh), j = 32 * tj + l31; ao[i * 64 + j] = (bf16)f2bf(j <= i ? acc[r] : 0.f); }
        }
        __syncthreads();
    }
}

DI void ph_gla_scan(const Ctx& C) {
    const bf16* proj = (const bf16*)(C.ws + WS_BIG);
    const bf16* attn_all = (const bf16*)(C.ws + WS_HN);
    const float* decay_all = (const float*)(C.ws + WS_DECAY);
    bf16* oraw = (bf16*)(C.ws + WS_F + (size_t)RT * 512 * 4);
    const int lane = C.lane, l31 = lane & 31, hh = lane >> 5, sl = C.wave;
    for (int bh = blockIdx.x; bh < NBATCH * 4; bh += C.G) {
        const int b = bh >> 2, h = bh & 3;
        f32x16 S[4];
#pragma unroll
        for (int t = 0; t < 4; ++t)
#pragma unroll
            for (int r = 0; r < 16; ++r) S[t][r] = 0.f;
        for (int n = 0; n < 65; ++n) {
            const int row0 = b * SEQ + 64 * (n - 1);
            const bf16* ob = n == 0 ? (const bf16*)(C.ws + WS_C0) : proj + (size_t)row0 * NIN;
            const int id = chunkhead_id(b, n, h);
            const bf16* at = attn_all + (size_t)id * 4096; const float* dc = decay_all + (size_t)id * 128;
            const int dv = 32 * sl + l31;
            bf16x8 vB[4];
#pragma unroll
            for (int s = 0; s < 4; ++s) vB[s] = *(const bf16x8*)(ob + (size_t)(dv >> 2) * NIN + 1024 + h * 256 + (dv & 3) * 64 + 16 * s + 8 * hh);
            bf16x8 Sb[4][2];
#pragma unroll
            for (int t = 0; t < 4; ++t) { Sb[t][0] = pack8<0>(S[t]); Sb[t][1] = pack8<1>(S[t]); }
            f32x16 o[2];
#pragma unroll
            for (int mt = 0; mt < 2; ++mt) {
#pragma unroll
                for (int r = 0; r < 16; ++r) o[mt][r] = 0.f;
                const bf16* qrow = ob + (size_t)(32 * mt + l31) * NIN + h * 128 + 4 * hh;
#pragma unroll
                for (int t = 0; t < 4; ++t)
#pragma unroll
                    for (int s = 0; s < 2; ++s) o[mt] = MFMA32(ld_perm(qrow + 32 * t + 16 * s), Sb[t][s], o[mt]);
                const bf16* arow = at + (32 * mt + l31) * 64 + 8 * hh;
#pragma unroll
                for (int s = 0; s < 4; ++s) o[mt] = MFMA32(*(const bf16x8*)(arow + 16 * s), vB[s], o[mt]);
            }
#pragma unroll
            for (int t = 0; t < 4; ++t) {
#pragma unroll
                for (int gq = 0; gq < 4; ++gq) { const f32x4 d4 = *(const f32x4*)(dc + 32 * t + 8 * gq + 4 * hh);
                    S[t][4 * gq] *= d4.x; S[t][4 * gq + 1] *= d4.y; S[t][4 * gq + 2] *= d4.z; S[t][4 * gq + 3] *= d4.w; }
                const int dk = 32 * t + l31;
                const bf16* krow = ob + (size_t)(dk >> 1) * NIN + 512 + h * 128 + (dk & 1) * 64 + 8 * hh;
#pragma unroll
                for (int s = 0; s < 4; ++s) S[t] = MFMA32(*(const bf16x8*)(krow + 16 * s), vB[s], S[t]);
            }
            if (n > 0) {
#pragma unroll
                for (int mt = 0; mt < 2; ++mt)
#pragma unroll
                    for (int r = 0; r < 16; ++r) oraw[(size_t)(row0 + 32 * mt + crow(r, hh)) * D + h * 256 + dv] = (bf16)f2bf(o[mt][r]);
            }
        }
    }
}
DI void ph_dn_chunk_prep(const Ctx& C) {
    bf16* proj = (bf16*)(C.ws + WS_BIG);
    bf16* qkv = (bf16*)(C.ws + WS_F);
    const float* gates = (const float*)(C.ws + WS_GATES);
    float* glast_all = (float*)(C.ws + WS_DECAY);
    LAS bf16* QL = (LAS bf16*)(C.lds); LAS bf16* KL = (LAS bf16*)(C.lds + 17408); LAS bf16* VL = (LAS bf16*)(C.lds + 34816);
    LAS bf16* KDT = (LAS bf16*)(C.lds + 52224); LAS bf16* VBT = (LAS bf16*)(C.lds + 70656);
    LAS float* AM = (LAS float*)(C.lds + 89088);
    LAS float* SC = (LAS float*)(C.lds + 106496);
    const int t = C.tid, lane = C.lane, wave = C.wave, l31 = lane & 31, hh = lane >> 5;
    for (int job = blockIdx.x; job < N_CHUNKHEADS; job += C.G) {
        int b, n, h; if (job < 4) { b = 0; n = 0; h = job; } else { const int x = job - 4; h = x & 3; n = ((x >> 2) & 63) + 1; b = x >> 8; }
        const int in_row0 = n == 0 ? MR - 48 : b * SEQ + 64 * (n - 1), vfrom = n == 0 ? 48 : 0;
        const bf16* inq = qkv + (size_t)in_row0 * 1536;
        bf16* oq = n == 0 ? (bf16*)(C.ws + WS_C0Q) : qkv + (size_t)in_row0 * 1536;
        bf16* op = n == 0 ? (bf16*)(C.ws + WS_C0) : proj + (size_t)in_row0 * NIN;
#pragma unroll
        for (int q = 0; q < 2; ++q) { const int p = t + 512 * q, row = p >> 4, c8 = (p & 15) * 8;
            v4u vq = {0u, 0u, 0u, 0u}, vk = vq, vv = vq;
            if (row >= vfrom) { const bf16* src = inq + (size_t)row * 1536 + h * 128 + c8; vq = *(const v4u*)src; vk = *(const v4u*)(src + 512); vv = *(const v4u*)(src + 1024); }
            *(LAS v4u*)(QL + row * 136 + c8) = vq; *(LAS v4u*)(KL + row * 136 + c8) = vk; *(LAS v4u*)(VL + row * 136 + c8) = vv; }
        if (wave == 0) {
            float g = 0.f, be = 0.f;
            if (lane >= vfrom) { g = gates[(size_t)(in_row0 + lane) * 16 + 12 + h]; be = gates[(size_t)(in_row0 + lane) * 16 + 8 + h]; }
            float x = g;
#pragma unroll
            for (int o = 1; o < 64; o <<= 1) { const float y = __shfl_up(x, o); if (lane >= o) x += y; }
            const float gl = __int_as_float(__builtin_amdgcn_readlane(__float_as_int(x), 63));
            SC[lane] = x; SC[64 + lane] = be; SC[128 + lane] = __expf(x); SC[192 + lane] = __expf(gl - x);
            if (lane == 0) glast_all[job] = __expf(gl);
        }
        __syncthreads();
        if (wave < 4) {
            const int ti = wave >> 1, tj = wave & 1;
            if (tj <= ti) {
                f32x16 aq, ak;
#pragma unroll
                for (int r = 0; r < 16; ++r) { aq[r] = 0.f; ak[r] = 0.f; }
#pragma unroll
                for (int s = 0; s < 8; ++s) {
                    const bf16x8 fq_ = *(const LAS bf16x8*)(QL + (32 * ti + l31) * 136 + 16 * s + 8 * hh), fk_ = *(const LAS bf16x8*)(KL + (32 * ti + l31) * 136 + 16 * s + 8 * hh);
                    const bf16x8 bk_ = *(const LAS bf16x8*)(KL + (32 * tj + l31) * 136 + 16 * s + 8 * hh);
                    aq = MFMA32(fq_, bk_, aq); ak = MFMA32(fk_, bk_, ak);
                }
                const int j = 32 * tj + l31; const float gcj = SC[j];
#pragma unroll
                for (int r = 0; r < 16; ++r) { const int i = 32 * ti + crow(r, hh);
                    const float e = j <= i ? __expf(SC[i] - gcj) : 0.f;
                    op[(size_t)i * NIN + 768 + h * 384 + 192 + j] = (bf16)f2bf(aq[r] * e);
                    AM[i * 68 + j] = j < i ? SC[64 + i] * ak[r] * e : 0.f; }
            }
        } else {
            const int tt = t - 256;
#pragma unroll
            for (int q = 0; q < 4; ++q) { const int p = tt + 256 * q, row = p >> 4, c8 = (p & 15) * 8;
                const bf16x8 q8 = *(const LAS bf16x8*)(QL + row * 136 + c8), k8 = *(const LAS bf16x8*)(KL + row * 136 + c8), v8 = *(const LAS bf16x8*)(VL + row * 136 + c8);
                const float be = SC[64 + row], eg = SC[128 + row], egl = SC[192 + row];
                float qf[8], kf[8];
#pragma unroll
                for (int e = 0; e < 8; ++e) { qf[e] = bf2f((unsigned short)q8[e]) * eg; kf[e] = bf2f((unsigned short)k8[e]);
                    KDT[(c8 + e) * 72 + row] = (bf16)f2bf(kf[e] * egl); VBT[(c8 + e) * 72 + row] = (bf16)f2bf(bf2f((unsigned short)v8[e]) * be); }
                v4u o1; o1.x = pk2(qf[0], qf[1]); o1.y = pk2(qf[2], qf[3]); o1.z = pk2(qf[4], qf[5]); o1.w = pk2(qf[6], qf[7]);
                *(v4u*)(oq + (size_t)row * 1536 + h * 128 + c8) = o1;
                const float nb = -be * eg;
                v4u o2; o2.x = pk2(kf[0] * nb, kf[1] * nb); o2.y = pk2(kf[2] * nb, kf[3] * nb); o2.z = pk2(kf[4] * nb, kf[5] * nb); o2.w = pk2(kf[6] * nb, kf[7] * nb);
                *(v4u*)(op + (size_t)row * NIN + 768 + h * 384 + c8) = o2; }
        }
        __syncthreads();
        if (wave == 0) {
            LAS bf16* TL = QL;
            float tc[64];
            int lv = lane; asm volatile("" : "+v"(lv));
#pragma unroll
            for (int i = 0; i < 64; ++i) {
                float a = (i == lv) ? 1.f : 0.f;
#pragma unroll
                for (int m4 = 0; m4 < i; m4 += 4) { const f32x4 am = *(const LAS f32x4*)(AM + i * 68 + m4);
                    a -= am.x * tc[m4]; if (m4 + 1 < i) a -= am.y * tc[m4 + 1]; if (m4 + 2 < i) a -= am.z * tc[m4 + 2]; if (m4 + 3 < i) a -= am.w * tc[m4 + 3]; }
                tc[i] = a;
                TL[i * 72 + lane] = (bf16)f2bf(a);
            }
            LDS_WAIT();
            bf16* tp = op + 768 + h * 384 + 128;
            for (int p = lane; p < 512; p += 64) { const int i = p >> 3, j8 = (p & 7) * 8; *(v4u*)(tp + (size_t)i * NIN + j8) = *(const LAS v4u*)(TL + i * 72 + j8); }
        } else {
            for (int p = t - 64; p < 2048; p += 448) { const int which = p >> 10, pp = p & 1023, dd = pp >> 3, i8 = (pp & 7) * 8;
                const v4u v = *(const LAS v4u*)((which ? VBT : KDT) + dd * 72 + i8);
                *(v4u*)(oq + (size_t)(dd >> 1) * 1536 + 512 + which * 512 + h * 128 + (dd & 1) * 64 + i8) = v; }
        }
        __syncthreads();
    }
}

DI void cvt4(f32x16& x, int g, v2u w) { x[4 * g] = bflo(w.x); x[4 * g + 1] = bfhi(w.x); x[4 * g + 2] = bflo(w.y); x[4 * g + 3] = bfhi(w.y); }
DI void ph_dn_scan(const Ctx& C) {
    const bf16* proj = (const bf16*)(C.ws + WS_BIG);
    const bf16* qkv = (const bf16*)(C.ws + WS_F);
    const float* glast_all = (const float*)(C.ws + WS_DECAY);
    bf16* oraw = (bf16*)(C.ws + WS_F + (size_t)RT * 1536 * 2);
    const int lane = C.lane, l31 = lane & 31, hh = lane >> 5, sl = C.wave & 3;
    for (int bh = blockIdx.x * 2 + (C.wave >> 2); bh < NBATCH * 4; bh += C.G * 2) {
        const int b = bh >> 2, h = bh & 3;
        f32x16 S[4];
#pragma unroll
        for (int t = 0; t < 4; ++t)
#pragma unroll
            for (int r = 0; r < 16; ++r) S[t][r] = 0.f;
        const int dv = 32 * sl + l31;
        for (int n = 0; n < 65; ++n) {
            const int row0 = b * SEQ + 64 * (n - 1);
            const bf16* oq = n == 0 ? (const bf16*)(C.ws + WS_C0Q) : qkv + (size_t)row0 * 1536;
            const bf16* op = (n == 0 ? (const bf16*)(C.ws + WS_C0) : proj + (size_t)row0 * NIN) + 768 + h * 384;
            const float glast = glast_all[chunkhead_id(b, n, h)];
            bf16x8 Sb[4][2];
#pragma unroll
            for (int t = 0; t < 4; ++t) { Sb[t][0] = pack8<0>(S[t]); Sb[t][1] = pack8<1>(S[t]); }
            f32x16 X[2];
            const bf16* vrow = oq + (size_t)(dv >> 1) * 1536 + 1024 + h * 128 + (dv & 1) * 64 + 4 * hh;
#pragma unroll
            for (int mt = 0; mt < 2; ++mt) {
#pragma unroll
                for (int g = 0; g < 4; ++g) cvt4(X[mt], g, *(const v2u*)(vrow + 32 * mt + 8 * g));
                const bf16* krow = op + (size_t)(32 * mt + l31) * NIN + 4 * hh;
#pragma unroll
                for (int t = 0; t < 4; ++t)
#pragma unroll
                    for (int s = 0; s < 2; ++s) X[mt] = MFMA32(ld_perm(krow + 32 * t + 16 * s), Sb[t][s], X[mt]);
            }
            f32x16 o[2];
#pragma unroll
            for (int mt = 0; mt < 2; ++mt) {
#pragma unroll
                for (int r = 0; r < 16; ++r) o[mt][r] = 0.f;
                const bf16* qrow = oq + (size_t)(32 * mt + l31) * 1536 + h * 128 + 4 * hh;
#pragma unroll
                for (int t = 0; t < 4; ++t)
#pragma unroll
                    for (int s = 0; s < 2; ++s) o[mt] = MFMA32(ld_perm(qrow + 32 * t + 16 * s), Sb[t][s], o[mt]);
            }
            bf16x8 Xb[2][2];
#pragma unroll
            for (int mt = 0; mt < 2; ++mt) { Xb[mt][0] = pack8<0>(X[mt]); Xb[mt][1] = pack8<1>(X[mt]); }
            f32x16 V[2];
#pragma unroll
            for (int mt = 0; mt < 2; ++mt) {
#pragma unroll
                for (int r = 0; r < 16; ++r) V[mt][r] = 0.f;
                const bf16* trow = op + (size_t)(32 * mt + l31) * NIN + 128 + 4 * hh;
#pragma unroll
                for (int mx = 0; mx < 2; ++mx) if (mx <= mt) {
#pragma unroll
                    for (int s = 0; s < 2; ++s) V[mt] = MFMA32(ld_perm(trow + 32 * mx + 16 * s), Xb[mx][s], V[mt]); }
            }
            bf16x8 Vb[2][2];
#pragma unroll
            for (int mt = 0; mt < 2; ++mt) { Vb[mt][0] = pack8<0>(V[mt]); Vb[mt][1] = pack8<1>(V[mt]); }
#pragma unroll
            for (int mt = 0; mt < 2; ++mt) {
                const bf16* arow = op + (size_t)(32 * mt + l31) * NIN + 192 + 4 * hh;
#pragma unroll
                for (int mx = 0; mx < 2; ++mx) if (mx <= mt) {
#pragma unroll
                    for (int s = 0; s < 2; ++s) o[mt] = MFMA32(ld_perm(arow + 32 * mx + 16 * s), Vb[mx][s], o[mt]); }
            }
#pragma unroll
            for (int t = 0; t < 4; ++t) {
#pragma unroll
                for (int r = 0; r < 16; ++r) S[t][r] *= glast;
                const int dk = 32 * t + l31;
                const bf16* kd = oq + (size_t)(dk >> 1) * 1536 + 512 + h * 128 + (dk & 1) * 64 + 4 * hh;
#pragma unroll
                for (int mx = 0; mx < 2; ++mx)
#pragma unroll
                    for (int s = 0; s < 2; ++s) S[t] = MFMA32(ld_perm(kd + 32 * mx + 16 * s), Vb[mx][s], S[t]);
            }
            if (n > 0 || b == 0) {
#pragma unroll
                for (int mt = 0; mt < 2; ++mt)
#pragma unroll
                    for (int r = 0; r < 16; ++r) { const int i = 32 * mt + crow(r, hh);
                        if (n > 0) oraw[(size_t)(row0 + i) * 512 + h * 128 + dv] = (bf16)f2bf(o[mt][r]);
                        else if (i >= 48) oraw[(size_t)(MR + i - 48) * 512 + h * 128 + dv] = (bf16)f2bf(o[mt][r]); }
            }
        }
    }
}
struct Args { const float* in[19]; float* out; unsigned char* ws; int ph_lo, ph_hi; };
static_assert(sizeof(Args) == 19 * 8 + 8 + 8 + 8, "Args has no padding");
constexpr int CW_BAR = 4096;

template <int N, int K, class Epi>
DI void run_gemm(const Ctx& C, const bf16* A, const bf16* Bt, const Epi& E) {
    pg8::Gemm g{A, Bt, RT, N, K}; pg8::StaticOrder S; S.init(RT, N, C.G, (int)blockIdx.x);
    pg8::gemm_phase<Epi, pg8::StaticOrder, true, true>(C.lds, g, S, E);
}

__global__ void __launch_bounds__(NTHREADS, 2) mk_fwd(Args args) {
    extern __shared__ __attribute__((aligned(16))) unsigned char lds_raw[];
    Ctx C;
    C.lds = (LAS unsigned char*)lds_raw;
    C.tid = threadIdx.x; C.lane = C.tid & 63; C.wave = __builtin_amdgcn_readfirstlane(C.tid >> 6);
    C.G = gridDim.x; C.gw = blockIdx.x * NWAVES + C.wave; C.NGW = C.G * NWAVES;
#pragma unroll
    for (int i = 0; i < 19; ++i) C.in[i] = args.in[i];
    C.out = args.out; C.ws = args.ws;
    unsigned char* const ws = args.ws;
    for (int u = C.tid; u < (LDS_BYTES - LDSCTL_OFF) / 4; u += NTHREADS) ((LAS unsigned*)(C.lds + LDSCTL_OFF))[u] = 0u;
    __syncthreads();
#if MK_ONE_LAUNCH
    XcdBarrier bar = xcd_barrier_post((unsigned*)(ws + WS_CTL) + CW_BAR, (volatile LAS unsigned*)(C.lds + MISC_OFF) + 8);
#define SEAM(k) do { if (IN((k) + 1)) xcd_barrier(bar); } while (0)
#else
#define SEAM(k) do { } while (0)
#endif
    const int lo = args.ph_lo, hi = args.ph_hi;
#define IN(k) (lo <= (k) && (k) < hi)
#define HN_ ((bf16*)(ws + WS_HN))
#define BIG_ ((bf16*)(ws + WS_BIG))
#define F_ ((float*)(ws + WS_F))
    if (IN(0)) { ph_prologue(C); SEAM(0); }
#define FFN_PHASES(P, L, WGU, WDN, WHICH, CONV) \
    if (IN(P)) { pg8::EpiSwiGLU E{BIG_, FF}; run_gemm<2 * FF, D>(C, HN_, (const bf16*)(ws + (WGU)), E); SEAM(P); } \
    if (IN(P + 1)) { pg8::EpiF32 E{F_, D}; run_gemm<D, FF>(C, BIG_, (const bf16*)(ws + (WDN)), E); SEAM(P + 1); } \
    if (IN(P + 2)) { ph_rownorm(C, L, WHICH); if (CONV) convert_weights(C, 1); SEAM(P + 2); }
    FFN_PHASES(1, 0, WS_WGU_A, WS_WDN_A, 0, false)
    if (IN(4)) { pg8::EpiProj E{BIG_, NIN, (float*)(ws + WS_GATES), 11}; run_gemm<NIN, D>(C, HN_, (const bf16*)(ws + WS_WIN), E); SEAM(4); }
    if (IN(5)) { ph_dn_prep(C); ph_swa_naive(C); SEAM(5); }
    if (IN(6)) { ph_dn_chunk_prep(C); xcd_barrier(bar); ph_dn_scan(C); SEAM(6); }
    if (IN(7)) { ph_dn_gate(C); SEAM(7); }
    if (IN(8)) { pg8::EpiF32 E{F_, D}; run_gemm<D, D>(C, HN_, (const bf16*)(ws + WS_WOUT), E); SEAM(8); }
    if (IN(9)) { ph_rownorm(C, 0, 1); SEAM(9); }
    FFN_PHASES(10, 0, WS_WGU_B, WS_WDN_B, 2, true)
    FFN_PHASES(13, 1, WS_WGU_A, WS_WDN_A, 0, false)
    if (IN(16)) { pg8::EpiProj E{BIG_, NIN, (float*)(ws + WS_GATES), -1}; run_gemm<NIN, D>(C, HN_, (const bf16*)(ws + WS_WIN), E); SEAM(16); }
    if (IN(17)) { ph_gla_prep(C); SEAM(17); }
    if (IN(18)) { ph_gla_chunk_prep(C); xcd_barrier(bar); ph_gla_scan(C); SEAM(18); }
    if (IN(19)) { ph_gla_gate(C); SEAM(19); }
    if (IN(20)) { pg8::EpiF32 E{F_, D}; run_gemm<D, D>(C, HN_, (const bf16*)(ws + WS_WOUT), E); SEAM(20); }
    if (IN(21)) { ph_rownorm(C, 1, 1); SEAM(21); }
    FFN_PHASES(22, 1, WS_WGU_B, WS_WDN_B, 2, false)
}

extern "C" void kernel_launch(void* const* d_in, const int* in_sizes, int n_in, void* d_out, int out_size, void* d_ws, size_t ws_size, hipStream_t stream) {
    static int grid = 0;
    if (grid == 0) {
        if (n_in != 19 || out_size != MR * D || ws_size < WS_END2) { fprintf(stderr, "kernel_launch: unexpected shapes n_in %d out %d ws %zu (need %zu)\n", n_in, out_size, ws_size, (size_t)WS_END2); grid = -1; return; }
        int dev = 0, cus = 0, per_cu = 0;
        if (hipGetDevice(&dev) != hipSuccess || hipDeviceGetAttribute(&cus, hipDeviceAttributeMultiprocessorCount, dev) != hipSuccess) { grid = -1; return; }
        if (hipFuncSetAttribute((const void*)mk_fwd, hipFuncAttributeMaxDynamicSharedMemorySize, LDS_BYTES) != hipSuccess) { fprintf(stderr, "kernel_launch: hipFuncSetAttribute failed\n"); grid = -1; return; }
        if (hipOccupancyMaxActiveBlocksPerMultiprocessor(&per_cu, (const void*)mk_fwd, NTHREADS, LDS_BYTES) != hipSuccess || per_cu < 1) fprintf(stderr, "kernel_launch: occupancy query says %d\n", per_cu);
        (void)hipGetLastError();
        grid = cus;
    }
    if (grid < 0) return;
    (void)hipMemsetAsync((char*)d_ws + WS_CTL, 0, CTL_ZERO_BYTES, stream);
    Args a{};
    for (int i = 0; i < 19; ++i) a.in[i] = (const float*)d_in[i];
    a.out = (float*)d_out; a.ws = (unsigned char*)d_ws;
#if MK_ONE_LAUNCH
    a.ph_lo = 0; a.ph_hi = N_PHASES;
    hipLaunchKernelGGL(mk_fwd, dim3(grid), dim3(NTHREADS), LDS_BYTES, stream, a);
#else
    for (int ph = 0; ph < N_PHASES; ++ph) { a.ph_lo = ph; a.ph_hi = ph + 1; hipLaunchKernelGGL(mk_fwd, dim3(grid), dim3(NTHREADS), LDS_BYTES, stream, a); }
#endif
}
```

```cpp
#include <hip/hip_runtime.h>
#include <cstdio>
#include <cstdint>
#ifndef MK_ONE_LAUNCH
#define MK_ONE_LAUNCH 1
#endif
namespace pg8 {
#define PG8_LAS __attribute__((address_space(3)))
typedef unsigned short bf16_t;
typedef short bf16x8 __attribute__((ext_vector_type(8)));
typedef float f32x4 __attribute__((ext_vector_type(4)));
typedef unsigned u32x4 __attribute__((ext_vector_type(4)));
constexpr int BM = 256, BK = 64, HALF = 128, HTB = HALF * BK * 2  , STAGE_BYTES = 8 * HTB, NXCD = 8, WGM = 8;

__host__ __device__ __forceinline__ int lds_byte(int r, int c) { const int st = (r >> 4) * 2 + (c >> 5), rr = r & 15, cc = c & 31, ob = rr * 64 + cc * 2; return st * 1024 + (ob ^ (((ob >> 9) & 1) << 5)); }
__host__ __device__ __forceinline__ void stage_rc(int b, int& R, int& C) { const int st = b / 1024, sb = b % 1024, swz = sb ^ (((sb >> 9) & 1) << 5); R = (st >> 1) * 16 + swz / 64; C = (st & 1) * 32 + (swz % 64) / 2; }
__host__ __device__ __forceinline__ int perm32(int rho) { const int n = rho >> 4, i = rho & 15; return 8 * (i >> 2) + 4 * n + (i & 3); }

struct Unit { int pm, pn; };
struct Gemm { const bf16_t* A; const bf16_t* Bt; int M, N, K; };

struct StaticOrder {
    int nM, nN, nwg, G, c;
    __host__ __device__ void init(int M, int N, int G_, int c_) { nM = M / BM; nN = N / BM; nwg = nM * nN; G = G_; c = c_; }
    __host__ __device__ bool next(int i, Unit& u) const {
        const long L = (long)i * G + c; if (L >= nwg) return false;
        int wgid = (int)L; { const int q = nwg / NXCD, r = nwg % NXCD, xcd = wgid % NXCD, off = wgid / NXCD; wgid = (xcd < r ? xcd * (q + 1) : r * (q + 1) + (xcd - r) * q) + off; }
        const int nig = WGM * nN, gid = wgid / nig, fm = gid * WGM, gsz = (nM - fm) < WGM ? (nM - fm) : WGM;
        u.pm = fm + ((wgid % nig) % gsz); u.pn = (wgid % nig) / gsz; return true;
    }
    __device__ __forceinline__ void a_ready(const Unit&) const {}
    __device__ __forceinline__ void done(const Unit&) const {}
};

__device__ __forceinline__ unsigned cvt_pk_bf16(float lo, float hi) { unsigned r; asm volatile("v_cvt_pk_bf16_f32 %0, %1, %2" : "=v"(r) : "v"(lo), "v"(hi)); return r; }
typedef float f32x2 __attribute__((ext_vector_type(2)));
__device__ __forceinline__ float fast_silu(float x) { return x * __builtin_amdgcn_rcpf(1.0f + __builtin_amdgcn_exp2f(-1.4426950408889634f * x)); }
struct EpiSwiGLU {
    static constexpr bool PERM = true, AFTER_DRAIN = false;
    bf16_t* O; int ldc;
    __device__ __forceinline__ void operator()(const f32x4 (&acc)[2][2][4][2], const Unit& u, int wr, int wc, int fr, int fq) const {
        const int row0 = u.pm * BM + wr * 64 + fr, col0 = u.pn * HALF + wc * 32 + 8 * fq;
#pragma unroll
        for (int ai = 0; ai < 2; ++ai)
#pragma unroll
            for (int m = 0; m < 4; ++m) {
                bf16_t* p = O + (size_t)(row0 + ai * HALF + m * 16) * ldc + col0;
                const f32x4 g0 = acc[ai][0][m][0], g1 = acc[ai][0][m][1], u0 = acc[ai][1][m][0], u1 = acc[ai][1][m][1];
                u32x4 w;
                w.x = cvt_pk_bf16(fast_silu(g0[0]) * u0[0], fast_silu(g0[1]) * u0[1]); w.y = cvt_pk_bf16(fast_silu(g0[2]) * u0[2], fast_silu(g0[3]) * u0[3]);
                w.z = cvt_pk_bf16(fast_silu(g1[0]) * u1[0], fast_silu(g1[1]) * u1[1]); w.w = cvt_pk_bf16(fast_silu(g1[2]) * u1[2], fast_silu(g1[3]) * u1[3]);
                *(u32x4*)p = w;
            }
    }
};
struct EpiF32 {
    static constexpr bool PERM = false, AFTER_DRAIN = false;
    float* O; int ldc;
    __device__ __forceinline__ void operator()(const f32x4 (&acc)[2][2][4][2], const Unit& u, int wr, int wc, int fr, int fq) const {
        const int row0 = u.pm * BM + wr * 64 + fr, col0 = u.pn * BM + wc * 32 + 4 * fq;
#pragma unroll
        for (int ai = 0; ai < 2; ++ai)
#pragma unroll
            for (int m = 0; m < 4; ++m) {
                float* p = O + (size_t)(row0 + ai * HALF + m * 16) * ldc + col0;
#pragma unroll
                for (int bj = 0; bj < 2; ++bj)
#pragma unroll
                    for (int n = 0; n < 2; ++n) *(f32x4*)(p + bj * HALF + n * 16) = acc[ai][bj][m][n];
            }
    }
};
struct EpiProj {
    static constexpr bool PERM = true, AFTER_DRAIN = false;
    bf16_t* O; int ldc; float* side; int side_pn;
    __device__ __forceinline__ void operator()(const f32x4 (&acc)[2][2][4][2], const Unit& u, int wr, int wc, int fr, int fq) const {
        const int row0 = u.pm * BM + wr * 64 + fr, col0 = u.pn * BM + wc * 32 + 8 * fq;
        if (u.pn == side_pn) {
            if (wc == 0 && fq < 2) {
#pragma unroll
                for (int ai = 0; ai < 2; ++ai)
#pragma unroll
                    for (int m = 0; m < 4; ++m) { float* p = side + (size_t)(row0 + ai * HALF + m * 16) * 16 + 8 * fq;
                        *(f32x4*)p = acc[ai][0][m][0]; *(f32x4*)(p + 4) = acc[ai][0][m][1]; }
            }
            return;
        }
#pragma unroll
        for (int ai = 0; ai < 2; ++ai)
#pragma unroll
            for (int m = 0; m < 4; ++m) { bf16_t* rowp = O + (size_t)(row0 + ai * HALF + m * 16) * ldc + col0;
#pragma unroll
                for (int bj = 0; bj < 2; ++bj) { const f32x4 v0 = acc[ai][bj][m][0], v1 = acc[ai][bj][m][1];
                    u32x4 w; w.x = cvt_pk_bf16(v0[0], v0[1]); w.y = cvt_pk_bf16(v0[2], v0[3]); w.z = cvt_pk_bf16(v1[0], v1[1]); w.w = cvt_pk_bf16(v1[2], v1[3]);
                    *(u32x4*)(rowp + bj * HALF) = w; } }
    }
};
template <class Epi, class Sched, bool ALIGN_EPI = false, bool SP2 = false>
__device__ __forceinline__ void gemm_phase(PG8_LAS unsigned char* lds, const Gemm g, const Sched& S, const Epi& E) {
    const int tid = threadIdx.x, wid = __builtin_amdgcn_readfirstlane(tid >> 6), lane = tid & 63, wr = wid >> 2, wc = wid & 3, fr = lane & 15, fq = lane >> 4;
    const int K = g.K, nt = K / BK;
    unsigned voffA[2], voffB[2];
#pragma unroll
    for (int i = 0; i < 2; ++i) { int R, C; stage_rc(tid * 16 + i * 8192, R, C); const int Rb = Epi::PERM ? ((R & ~31) + perm32(R & 31)) : R;
        voffA[i] = (unsigned)(R * K + C) * 2u; voffB[i] = (unsigned)(Rb * K + C) * 2u; }
    const size_t kstep = (size_t)(BK * 2);
    const size_t hstep = (size_t)HALF * K * 2;
    const size_t tstep = 2 * hstep;
    const unsigned ldsw = (unsigned)wid * 1024u;
    const int aoff = lds_byte(wr * 64 + fr, fq * 8), boff = lds_byte(wc * 32 + fr, fq * 8);
#define PG8_SA(b, h) (((b) * 2 + (h)) * HTB)
#define PG8_SB(b, h) ((4 + (b) * 2 + (h)) * HTB)
#define PG8_STAGE(bufoff, gbase, voff) do { _Pragma("unroll") for (int _i = 0; _i < 2; ++_i) \
        __builtin_amdgcn_global_load_lds((const unsigned*)((const char*)(gbase) + (voff)[_i]), (PG8_LAS unsigned*)(lds + (bufoff) + ldsw + _i * 8192), 16, 0, 0); } while (0)
#define PG8_LDA(dst, b, h) do { _Pragma("unroll") for (int m = 0; m < 4; ++m) _Pragma("unroll") for (int k = 0; k < 2; ++k) dst[m][k] = *(const PG8_LAS bf16x8*)(lds + PG8_SA(b, h) + aoff + m * 2048 + k * 1024); } while (0)
#define PG8_LDB(dst, b, h) do { _Pragma("unroll") for (int n = 0; n < 2; ++n) _Pragma("unroll") for (int k = 0; k < 2; ++k) dst[n][k] = *(const PG8_LAS bf16x8*)(lds + PG8_SB(b, h) + boff + n * 2048 + k * 1024); } while (0)
#define PG8_MMA(ai, bj, At, Bt) do { __builtin_amdgcn_s_setprio(1); _Pragma("unroll") for (int m = 0; m < 4; ++m) _Pragma("unroll") for (int n = 0; n < 2; ++n) _Pragma("unroll") for (int k = 0; k < 2; ++k) \
        acc[ai][bj][m][n] = __builtin_amdgcn_mfma_f32_16x16x32_bf16(Bt[n][k], At[m][k], acc[ai][bj][m][n], 0, 0, 0); __builtin_amdgcn_s_setprio(0); } while (0)
#define PG8_WAIT_V(n) asm volatile("s_waitcnt vmcnt(" #n ")" ::: "memory")
#define PG8_WAIT_L(n) asm volatile("s_waitcnt lgkmcnt(" #n ")" ::: "memory")
#define PG8_BAR __builtin_amdgcn_s_barrier()
#define PG8_SCHED __builtin_amdgcn_sched_barrier(0)
    Unit cur, nxt; int ui = 0;
    if (!S.next(0, cur)) return;
    f32x4 acc[2][2][4][2];
#pragma unroll
    for (int a = 0; a < 2; ++a)
#pragma unroll
        for (int b = 0; b < 2; ++b)
#pragma unroll
            for (int m = 0; m < 4; ++m)
#pragma unroll
                for (int n = 0; n < 2; ++n) acc[a][b][m][n] = (f32x4){0.f, 0.f, 0.f, 0.f};
    bf16x8 At[4][2], B0[2][2], B1[2][2];
    const char* cA = (const char*)g.A + (size_t)cur.pm * tstep; const char* cB = (const char*)g.Bt + (size_t)cur.pn * tstep;
    S.a_ready(cur);
    if constexpr (SP2) {
        PG8_STAGE(PG8_SB(0, 0), cB, voffB); PG8_STAGE(PG8_SB(0, 1), cB + hstep, voffB); PG8_STAGE(PG8_SA(0, 0), cA, voffA); PG8_STAGE(PG8_SA(0, 1), cA + hstep, voffA);
        if (wr == 1) PG8_BAR;
        PG8_WAIT_V(2); PG8_BAR;
        PG8_STAGE(PG8_SB(1, 0), cB + kstep, voffB); PG8_STAGE(PG8_SA(1, 0), cA + kstep, voffA); PG8_STAGE(PG8_SB(1, 1), cB + hstep + kstep, voffB);
        PG8_WAIT_V(6); PG8_BAR;
    } else {
        PG8_STAGE(PG8_SB(0, 0), cB, voffB); PG8_STAGE(PG8_SA(0, 0), cA, voffA); PG8_STAGE(PG8_SB(0, 1), cB + hstep, voffB); PG8_STAGE(PG8_SA(0, 1), cA + hstep, voffA);
        if (wr == 1) PG8_BAR;
        PG8_WAIT_V(4); PG8_BAR;
        PG8_STAGE(PG8_SB(1, 0), cB + kstep, voffB); PG8_STAGE(PG8_SA(1, 0), cA + kstep, voffA); PG8_STAGE(PG8_SB(1, 1), cB + hstep + kstep, voffB);
        PG8_WAIT_V(6); PG8_BAR;
    }
    for (;;) {
        const bool has_next = S.next(ui + 1, nxt);
        const char* nA = has_next ? (const char*)g.A + (size_t)nxt.pm * tstep : cA; const char* nB = has_next ? (const char*)g.Bt + (size_t)nxt.pn * tstep : cB;
        for (int t = 0; t < nt; t += 2) {
            const bool last = (t == nt - 2);
            const char* a1 = cA + (size_t)(t + 1) * kstep;
            const char* a2 = last ? nA : cA + (size_t)(t + 2) * kstep; const char* b2 = last ? nB : cB + (size_t)(t + 2) * kstep;
            const char* a3 = a2 + kstep; const char* b3 = b2 + kstep;
            if (last && has_next) S.a_ready(nxt);
            if constexpr (SP2) {
            PG8_LDB(B0, 0, 0); PG8_LDB(B1, 0, 1); PG8_SCHED; PG8_LDA(At, 0, 0); PG8_STAGE(PG8_SA(1, 1), a1 + hstep, voffA);
            PG8_WAIT_V(8); PG8_WAIT_L(0); PG8_BAR; PG8_MMA(0, 0, At, B0); PG8_MMA(0, 1, At, B1); PG8_BAR; PG8_SCHED;
            PG8_LDA(At, 0, 1); PG8_STAGE(PG8_SB(0, 0), b2, voffB); PG8_STAGE(PG8_SB(0, 1), b2 + hstep, voffB); PG8_STAGE(PG8_SA(0, 0), a2, voffA);
            PG8_WAIT_V(8); PG8_WAIT_L(0); PG8_BAR; PG8_MMA(1, 0, At, B0); PG8_MMA(1, 1, At, B1); PG8_BAR; PG8_SCHED;
            PG8_LDB(B0, 1, 0); PG8_LDB(B1, 1, 1); PG8_SCHED; PG8_LDA(At, 1, 0); PG8_STAGE(PG8_SA(0, 1), a2 + hstep, voffA);
            PG8_WAIT_V(8); PG8_WAIT_L(0); PG8_BAR; PG8_MMA(0, 0, At, B0); PG8_MMA(0, 1, At, B1); PG8_BAR; PG8_SCHED;
            PG8_LDA(At, 1, 1); PG8_STAGE(PG8_SB(1, 0), b3, voffB); PG8_STAGE(PG8_SB(1, 1), b3 + hstep, voffB); PG8_STAGE(PG8_SA(1, 0), a3, voffA);
            PG8_WAIT_V(8); PG8_WAIT_L(0); PG8_BAR; PG8_MMA(1, 0, At, B0); PG8_MMA(1, 1, At, B1); PG8_BAR; PG8_SCHED;
            } else {
            PG8_LDB(B0, 0, 0); PG8_SCHED; PG8_LDA(At, 0, 0); PG8_STAGE(PG8_SA(1, 1), a1 + hstep, voffA);
            PG8_WAIT_L(8); PG8_BAR; PG8_WAIT_L(0); PG8_MMA(0, 0, At, B0); PG8_BAR; PG8_SCHED;
            PG8_LDB(B1, 0, 1); PG8_STAGE(PG8_SB(0, 0), b2, voffB);
            PG8_BAR; PG8_WAIT_L(0); PG8_MMA(0, 1, At, B1); PG8_BAR;
            PG8_LDA(At, 0, 1); PG8_STAGE(PG8_SA(0, 0), a2, voffA);
            PG8_BAR; PG8_WAIT_L(0); PG8_MMA(1, 0, At, B0); PG8_BAR; PG8_SCHED;
            PG8_STAGE(PG8_SB(0, 1), b2 + hstep, voffB);
            PG8_WAIT_V(6); PG8_BAR; PG8_MMA(1, 1, At, B1); PG8_BAR;
            PG8_LDB(B0, 1, 0); PG8_SCHED; PG8_LDA(At, 1, 0); PG8_STAGE(PG8_SA(0, 1), a2 + hstep, voffA);
            PG8_WAIT_L(8); PG8_BAR; PG8_WAIT_L(0); PG8_MMA(0, 0, At, B0); PG8_BAR; PG8_SCHED;
            PG8_LDB(B1, 1, 1); PG8_STAGE(PG8_SB(1, 0), b3, voffB);
            PG8_BAR; PG8_WAIT_L(0); PG8_MMA(0, 1, At, B1); PG8_BAR;
            PG8_LDA(At, 1, 1); PG8_STAGE(PG8_SA(1, 0), a3, voffA);
            PG8_BAR; PG8_WAIT_L(0); PG8_MMA(1, 0, At, B0); PG8_BAR; PG8_SCHED;
            PG8_STAGE(PG8_SB(1, 1), b3 + hstep, voffB);
            PG8_WAIT_V(6); PG8_BAR; PG8_MMA(1, 1, At, B1); PG8_BAR;
            }
        }
        if constexpr (ALIGN_EPI) { if (wr == 0) PG8_BAR; }
        if constexpr (!Epi::AFTER_DRAIN) { E(acc, cur, wr, wc, fr, fq); S.done(cur); }
        if (!has_next) break;
#pragma unroll
        for (int a = 0; a < 2; ++a)
#pragma unroll
            for (int b = 0; b < 2; ++b)
#pragma unroll
                for (int m = 0; m < 4; ++m)
#pragma unroll
                    for (int n = 0; n < 2; ++n) acc[a][b][m][n] = (f32x4){0.f, 0.f, 0.f, 0.f};
        cur = nxt; cA = nA; cB = nB; ++ui;
        if constexpr (ALIGN_EPI) { if (wr == 1) PG8_BAR; }
    }
    PG8_WAIT_V(0);
    if constexpr (!ALIGN_EPI) { if (wr == 0) PG8_BAR; }
    PG8_BAR;
    if constexpr (Epi::AFTER_DRAIN) { E.fused(acc, cur, wr, wc, fr, fq, lds, wid, lane); S.done(cur); }
#undef PG8_SA
#undef PG8_SB
#undef PG8_STAGE
#undef PG8_LDA
#undef PG8_LDB
#undef PG8_MMA
#undef PG8_WAIT_V
#undef PG8_WAIT_L
#undef PG8_BAR
#undef PG8_SCHED
}
}
#define RLX_AGENT __ATOMIC_RELAXED, __HIP_MEMORY_SCOPE_AGENT
#define DI __device__ __forceinline__
#define LAS __attribute__((address_space(3)))
typedef unsigned short bf16;
typedef float f32x4 __attribute__((ext_vector_type(4)));
typedef float f32x2 __attribute__((ext_vector_type(2)));
typedef short bf16x8 __attribute__((ext_vector_type(8)));
typedef unsigned v4u __attribute__((ext_vector_type(4)));
typedef unsigned v2u __attribute__((ext_vector_type(2)));

constexpr int D = 1024, FF = 2816, NBATCH = 4, SEQ = 4096, NMETA = 16, LSEQ = SEQ + NMETA, MR = NBATCH * SEQ, RV = MR + NMETA, RT = 16640;
constexpr int NIN = 3072;
constexpr float EPS = 1e-6f;
constexpr int NWAVES = 8, NTHREADS = 512;
constexpr int N_PHASES = 25;

constexpr size_t MiB = 1u << 20;
constexpr size_t WS_CTL = 0, CTL_ZERO_BYTES = 1 * MiB;
constexpr size_t WS_HMETA = 1 * MiB;
constexpr size_t WS_GATES = 2 * MiB;
constexpr size_t WS_WGU_A = 4 * MiB, WS_WDN_A = 15 * MiB, WS_WGU_B = 21 * MiB, WS_WDN_B = 32 * MiB, WS_WIN = 38 * MiB, WS_WOUT = 44 * MiB;
constexpr size_t WS_HN = 46 * MiB;
constexpr size_t WS_BIG = 79 * MiB;
constexpr size_t WS_F = 177 * MiB;
constexpr size_t WS_WGK = 242 * MiB;
constexpr size_t WS_END = 243 * MiB;
static_assert(WS_HN + (size_t)RT * D * 2 <= WS_BIG && WS_BIG + (size_t)RT * NIN * 2 <= WS_F && WS_F + (size_t)RT * D * 4 <= WS_WGK, "d_ws map");

constexpr int RING_BYTES = 131072, LDSCTL_OFF = RING_BYTES, MISC_OFF = LDSCTL_OFF + 320, LDS_BYTES = 147456;

DI float bf2f(unsigned v) { return __uint_as_float(v << 16); }
DI unsigned f2bf(float f) { unsigned u = __float_as_uint(f); return (u + 0x7fffu + ((u >> 16) & 1u)) >> 16; }
DI unsigned pk2(float lo, float hi) { return f2bf(lo) | (f2bf(hi) << 16); }
DI float bflo(unsigned w) { return __uint_as_float(w << 16); }
DI float bfhi(unsigned w) { return __uint_as_float(w & 0xffff0000u); }
#define LDS_WAIT() asm volatile("s_waitcnt lgkmcnt(0)" ::: "memory")

DI float dpp_f(float x, int ctrl_unused) { return x; }
#define DPP_ADD(x, ctrl) ((x) + __int_as_float(__builtin_amdgcn_update_dpp(0, __float_as_int(x), (ctrl), 0xF, 0xF, true)))
DI float row16_sum(float v) { v = DPP_ADD(v, 0xB1); v = DPP_ADD(v, 0x4E); v = DPP_ADD(v, 0x141); v = DPP_ADD(v, 0x140); return v; }
DI float wave_sum(float v) {
    v = row16_sum(v);
    const int i = __float_as_int(v);
    return __int_as_float(__builtin_amdgcn_readlane(i, 0)) + __int_as_float(__builtin_amdgcn_readlane(i, 16)) + __int_as_float(__builtin_amdgcn_readlane(i, 32)) + __int_as_float(__builtin_amdgcn_readlane(i, 48));
}
DI float wave_max(float v) {
#pragma unroll
    for (int o = 1; o < 64; o <<= 1) v = fmaxf(v, __shfl_xor(v, o));
    return v;
}
DI float sigmoidf_(float x) { return 1.0f / (1.0f + __expf(-x)); }
DI float siluf_(float x) { return x / (1.0f + __expf(-x)); }
DI float softplusf_(float x) { return fmaxf(x, 0.f) + log1pf(__expf(-fabsf(x))); }
DI float logsigmoidf_(float x) { return fminf(x, 0.f) - log1pf(__expf(-fabsf(x))); }

struct Ctx {
    LAS unsigned char* lds;
    int tid, lane, wave, G, gw, NGW;
    const float* in[19];
    float* out; unsigned char* ws;
};
DI int pos_to_row(int b, int p) { return p < NMETA ? MR + p : b * SEQ + (p - NMETA); }
DI float* h_ptr(const Ctx& C, int r) { return r < MR ? C.out + (size_t)r * D : (float*)(C.ws + WS_HMETA) + (size_t)(r - MR) * D; }

struct SrcCol { const float* W; int N; int col; };
template <class Map>
DI void transpose_items(const Ctx& C, const Map mp, int K, int ND, bf16* WT) {
    LAS float* scr = (LAS float*)(C.lds + C.wave * 16384);
    const int lane = C.lane, ndb = ND / 32, items = (K / 64) * ndb;
    for (int it = C.gw; it < items; it += C.NGW) {
        const int kb = it / ndb, db = it % ndb, k0 = 64 * kb, d0 = 32 * db;
        const SrcCol sc = mp(d0 + (lane & 31));
#pragma unroll 8
        for (int i = 0; i < 32; ++i) { const int kk = 2 * i + (lane >> 5); scr[kk * 33 + (lane & 31)] = sc.col >= 0 ? sc.W[(size_t)(k0 + kk) * sc.N + sc.col] : 0.f; }
        LDS_WAIT(); asm volatile("" ::: "memory");
        const int c = lane & 7;
#pragma unroll
        for (int j = 0; j < 4; ++j) { const int n = (lane >> 3) + 8 * j; const LAS float* s = scr + (8 * c) * 33 + n;
            v4u o; o.x = pk2(s[0 * 33], s[1 * 33]); o.y = pk2(s[2 * 33], s[3 * 33]); o.z = pk2(s[4 * 33], s[5 * 33]); o.w = pk2(s[6 * 33], s[7 * 33]);
            *(v4u*)(WT + (size_t)(d0 + n) * K + k0 + 8 * c) = o; }
        LDS_WAIT(); asm volatile("" ::: "memory");
    }
}
struct MapIdent { const float* W; int N; int off; int nvalid; DI SrcCol operator()(int d) const { SrcCol s; s.W = W; s.N = N; s.col = d < nvalid ? off + d : -1; return s; } };
struct MapGateUp { const float* Wg; const float* Wu; DI SrcCol operator()(int d) const { const int t = d >> 8, w = d & 255; SrcCol s; s.N = FF;
    const unsigned long long dlt = (unsigned long long)(uintptr_t)Wu - (unsigned long long)(uintptr_t)Wg; s.W = (const float*)((uintptr_t)Wg + (w < 128 ? 0ull : dlt)); s.col = 128 * t + (w & 127); return s; } };

DI void convert_weights(const Ctx& C, int l) {
    unsigned char* ws = C.ws;
    const size_t wgu = (size_t)D * FF, wdn = (size_t)FF * D;
    const float* g0 = C.in[3] + (size_t)(l * 2 + 0) * wgu; const float* u0 = C.in[4] + (size_t)(l * 2 + 0) * wgu; const float* d0 = C.in[5] + (size_t)(l * 2 + 0) * wdn;
    const float* g1 = C.in[3] + (size_t)(l * 2 + 1) * wgu; const float* u1 = C.in[4] + (size_t)(l * 2 + 1) * wgu; const float* d1 = C.in[5] + (size_t)(l * 2 + 1) * wdn;
    transpose_items(C, MapGateUp{g0, u0}, D, 2 * FF, (bf16*)(ws + WS_WGU_A));
    transpose_items(C, MapIdent{d0, D, 0, D}, FF, D, (bf16*)(ws + WS_WDN_A));
    transpose_items(C, MapGateUp{g1, u1}, D, 2 * FF, (bf16*)(ws + WS_WGU_B));
    transpose_items(C, MapIdent{d1, D, 0, D}, FF, D, (bf16*)(ws + WS_WDN_B));
    if (l == 0) {
        transpose_items(C, MapIdent{C.in[7], 2824, 0, 2824}, D, NIN, (bf16*)(ws + WS_WIN));
        transpose_items(C, MapIdent{C.in[13], D, 0, D}, D, D, (bf16*)(ws + WS_WOUT));
    } else {
        transpose_items(C, MapIdent{C.in[14], 3088, 0, 3072}, D, NIN, (bf16*)(ws + WS_WIN));
        transpose_items(C, MapIdent{C.in[18], D, 0, D}, D, D, (bf16*)(ws + WS_WOUT));
        transpose_items(C, MapIdent{C.in[14], 3088, 3072, 16}, D, 32, (bf16*)(ws + WS_WGK));
    }
}

DI void rms_row_to_bf16(const float* src, const float* w, bf16* dst, int lane) {
    f32x4 v[4]; float ss = 0.f;
#pragma unroll
    for (int j = 0; j < 4; ++j) { v[j] = ((const f32x4*)src)[lane + 64 * j]; ss += (v[j].x * v[j].x + v[j].y * v[j].y) + (v[j].z * v[j].z + v[j].w * v[j].w); }
    const float rstd = rsqrtf(wave_sum(ss) * (1.0f / D) + EPS);
#pragma unroll
    for (int j = 0; j < 4; ++j) { const f32x4 wv = ((const f32x4*)w)[lane + 64 * j]; const f32x4 o = v[j] * rstd * wv;
        v2u pk; pk.x = pk2(o.x, o.y); pk.y = pk2(o.z, o.w); ((v2u*)dst)[lane + 64 * j] = pk; }
}

DI void ph_prologue(const Ctx& C) {
    convert_weights(C, 0);
    bf16* hn = (bf16*)(C.ws + WS_HN);
    const float* nw0 = C.in[2];
    for (int r = C.gw; r < RT; r += C.NGW) {
        bf16* o = hn + (size_t)r * D;
        if (r >= RV) {
#pragma unroll
            for (int j = 0; j < 4; ++j) ((v2u*)o)[C.lane + 64 * j] = (v2u){0u, 0u};
        } else {
            const float* src = r < MR ? C.in[0] + (size_t)r * D : C.in[1] + (size_t)(r - MR) * D;
            rms_row_to_bf16(src, nw0, o, C.lane);
        }
    }
    float* hm = (float*)(C.ws + WS_HMETA);
    for (int r = NMETA + C.gw; r < 256; r += C.NGW) {
#pragma unroll
        for (int j = 0; j < 4; ++j) ((f32x4*)(hm + (size_t)r * D))[C.lane + 64 * j] = (f32x4){0.f, 0.f, 0.f, 0.f};
    }
}

DI void ph_rownorm(const Ctx& C, int l, int which) {
    const float* nw = C.in[2] + (size_t)l * 6 * D;
    const float* wa = nw + (which == 0 ? 1 : which == 1 ? 3 : 5) * D;
    const float scale = which == 1 ? 1.0f : 0.5f;
    const float* wb = which == 0 ? nw + 2 * D : which == 1 ? nw + 4 * D : (l == 0 ? C.in[2] + 6 * D : (const float*)nullptr);
    const bool first = (l == 0 && which == 0);
    const float* F = (const float*)(C.ws + WS_F);
    bf16* hn = (bf16*)(C.ws + WS_HN);
    const int lane = C.lane;
    for (int r = C.gw; r < RV; r += C.NGW) {
        const float* fr = F + (size_t)r * D;
        float* hp = h_ptr(C, r);
        const float* base = first ? (r < MR ? C.in[0] + (size_t)r * D : C.in[1] + (size_t)(r - MR) * D) : (const float*)hp;
        f32x4 v[4], hb[4]; float ss = 0.f;
#pragma unroll
        for (int j = 0; j < 4; ++j) { v[j] = ((const f32x4*)fr)[lane + 64 * j]; hb[j] = ((const f32x4*)base)[lane + 64 * j]; ss += (v[j].x * v[j].x + v[j].y * v[j].y) + (v[j].z * v[j].z + v[j].w * v[j].w); }
        const float rstd = rsqrtf(wave_sum(ss) * (1.0f / D) + EPS) * scale;
        float s2 = 0.f;
#pragma unroll
        for (int j = 0; j < 4; ++j) { const f32x4 wv = ((const f32x4*)wa)[lane + 64 * j]; hb[j] = hb[j] + v[j] * rstd * wv;
            ((f32x4*)hp)[lane + 64 * j] = hb[j]; s2 += (hb[j].x * hb[j].x + hb[j].y * hb[j].y) + (hb[j].z * hb[j].z + hb[j].w * hb[j].w); }
        if (wb) {
            const float r2 = rsqrtf(wave_sum(s2) * (1.0f / D) + EPS);
            bf16* o = hn + (size_t)r * D;
#pragma unroll
            for (int j = 0; j < 4; ++j) { const f32x4 wv = ((const f32x4*)wb)[lane + 64 * j]; const f32x4 y = hb[j] * r2 * wv;
                v2u pk; pk.x = pk2(y.x, y.y); pk.y = pk2(y.z, y.w); ((v2u*)o)[lane + 64 * j] = pk; }
        }
    }
}
#define XB_TMO      128
#define XB_XCNT(j)  (256  + 64 * (j))
#define XB_XSUB(j)  (1280 + 64 * (j))
#define XB_XGEN(j)  (2304 + 64 * (j))
#define XB_TOP      3328
#define XB_TOPGEN   3392
#define XCD_BAR_WORDS 3456
#define XB_SPIN_CAP (1u << 18)

__device__ __forceinline__ unsigned xb_ld(unsigned* p)              { return __hip_atomic_load(p, __ATOMIC_RELAXED, __HIP_MEMORY_SCOPE_AGENT); }
__device__ __forceinline__ unsigned xb_add(unsigned* p, unsigned v) { return __hip_atomic_fetch_add(p, v, __ATOMIC_RELAXED, __HIP_MEMORY_SCOPE_AGENT); }
__device__ __forceinline__ unsigned xb_xcc_id() { return (unsigned)__builtin_amdgcn_s_getreg((3 << 11) | 20) & 0xFu; }
#define XB_SPIN(cond, bar) do { unsigned _sp = 0; while (cond) { __builtin_amdgcn_s_sleep(1); \
    if ((++_sp & 255u) == 0u) { if (xb_ld(&(bar)[XB_TMO])) break; if (_sp > XB_SPIN_CAP) { atomicAdd(&(bar)[XB_TMO], 1u); break; } } } } while (0)

struct XcdBarrier {
    unsigned* bar; unsigned x;
    volatile LAS unsigned* st;
};

__device__ __forceinline__ XcdBarrier xcd_barrier_post(unsigned* bar, volatile LAS unsigned* st) {
    XcdBarrier b; b.bar = bar; b.x = xb_xcc_id(); b.st = st;
    if (threadIdx.x == 0) (void)xb_add(&bar[XB_XCNT(b.x)], 1u);
    return b;
}
__device__ __forceinline__ void xcd_barrier_complete(unsigned* bar, unsigned x, unsigned& nloc, unsigned& nx) {
    const unsigned G = gridDim.x * gridDim.y * gridDim.z;
    unsigned sum, cnt, mine, sp = 0u;
    for (;;) {
        sum = 0u; cnt = 0u; mine = 0u;
#pragma unroll
        for (unsigned j = 0; j < 16; ++j) { const unsigned c = xb_ld(&bar[XB_XCNT(j)]); sum += c; cnt += (c > 0u) ? 1u : 0u; mine = (j == x) ? c : mine; }
        if (sum == G) break;
        __builtin_amdgcn_s_sleep(1);
        if ((++sp & 255u) == 0u) { if (xb_ld(&bar[XB_TMO])) break; if (sp > XB_SPIN_CAP) { atomicAdd(&bar[XB_TMO], 1u); break; } }
    }
    nloc = mine > 0u ? mine : 1u; nx = cnt > 0u ? cnt : 1u;
}

__device__ __forceinline__ void xcd_barrier(const XcdBarrier& b) {
    asm volatile("s_waitcnt vmcnt(0)" ::: "memory");
    __syncthreads();
    if (threadIdx.x == 0) {
        unsigned* bar = b.bar;
        __builtin_amdgcn_s_waitcnt(0);
        unsigned nloc = b.st[0], nx = b.st[1];
        if (nloc == 0u) { xcd_barrier_complete(bar, b.x, nloc, nx); b.st[0] = nloc; b.st[1] = nx; }
        const unsigned old = xb_add(&bar[XB_XSUB(b.x)], 1u);
        const unsigned gen = old / nloc;
        if (old + 1u == (gen + 1u) * nloc) {
            __builtin_amdgcn_fence(__ATOMIC_RELEASE, "agent");
            asm volatile("s_waitcnt vmcnt(0)" ::: "memory");
            const unsigned og = xb_add(&bar[XB_TOP], 1u);
            const unsigned tg = og / nx;
            if (og + 1u == (tg + 1u) * nx) xb_add(&bar[XB_TOPGEN], 1u);
            else XB_SPIN(xb_ld(&bar[XB_TOPGEN]) == tg, bar);
            __builtin_amdgcn_fence(__ATOMIC_ACQUIRE, "agent");
            xb_add(&bar[XB_XGEN(b.x)], 1u);
            asm volatile("s_waitcnt vmcnt(0)" ::: "memory");
        } else {
            XB_SPIN(xb_ld(&bar[XB_XGEN(b.x)]) == gen, bar);
            __builtin_amdgcn_fence(__ATOMIC_ACQUIRE, "agent");
            asm volatile("s_waitcnt vmcnt(0)" ::: "memory");
        }
    }
    __syncthreads();
}
DI void ph_dn_prep(const Ctx& C) {
    const bf16* proj = (const bf16*)(C.ws + WS_BIG);
    bf16* qkv = (bf16*)(C.ws + WS_F);
    float* gates = (float*)(C.ws + WS_GATES);
    const float* convw = C.in[8];
    const int lane = C.lane;
    for (int r = C.gw; r < RV; r += C.NGW) {
        int b, p; if (r < MR) { b = r >> 12; p = NMETA + (r & (SEQ - 1)); } else { b = 0; p = r - MR; }
#pragma unroll
        for (int s = 0; s < 3; ++s) {
            const int c0 = 512 * s + 8 * lane;
            float y[8];
#pragma unroll
            for (int e = 0; e < 8; ++e) y[e] = 0.f;
#pragma unroll
            for (int j = 0; j < 4; ++j) {
                const int pp = p - 3 + j;
                if (pp >= 0) {
                    const int rr = pos_to_row(b, pp);
                    const bf16x8 xv = *(const bf16x8*)(proj + (size_t)rr * NIN + 768 + c0);
                    const f32x4 w0 = *(const f32x4*)(convw + j * 1536 + c0), w1 = *(const f32x4*)(convw + j * 1536 + c0 + 4);
                    y[0] += w0.x * bf2f((unsigned short)xv[0]); y[1] += w0.y * bf2f((unsigned short)xv[1]); y[2] += w0.z * bf2f((unsigned short)xv[2]); y[3] += w0.w * bf2f((unsigned short)xv[3]);
                    y[4] += w1.x * bf2f((unsigned short)xv[4]); y[5] += w1.y * bf2f((unsigned short)xv[5]); y[6] += w1.z * bf2f((unsigned short)xv[6]); y[7] += w1.w * bf2f((unsigned short)xv[7]);
                }
            }
            float ss = 0.f;
#pragma unroll
            for (int e = 0; e < 8; ++e) { y[e] = siluf_(y[e]); ss += y[e] * y[e]; }
            if (s < 2) {
                ss = row16_sum(ss);
                const float sc = rsqrtf(ss + 1e-6f) * (s == 0 ? 0.08838834764831845f : 1.0f);
#pragma unroll
                for (int e = 0; e < 8; ++e) y[e] *= sc;
            }
            v4u o; o.x = pk2(y[0], y[1]); o.y = pk2(y[2], y[3]); o.z = pk2(y[4], y[5]); o.w = pk2(y[6], y[7]);
            *(v4u*)(qkv + (size_t)r * 1536 + c0) = o;
        }
        if (lane < 4) gates[(size_t)r * 16 + 8 + lane] = sigmoidf_(gates[(size_t)r * 16 + lane]);
        else if (lane < 8) { const int h = lane - 4; const float a = gates[(size_t)r * 16 + 4 + h];
            gates[(size_t)r * 16 + 12 + h] = -__expf(C.in[10][h]) * softplusf_(a + C.in[11][h]); }
    }
}

DI int t5_bucket(int n) { if (n < 16) return n; const int v = 16 + (int)(logf((float)n * 0.0625f) * (16.0f / 2.0794415416798357f)); return v < 31 ? v : 31; }

DI void ph_dn_gate(const Ctx& C) {
    const bf16* proj = (const bf16*)(C.ws + WS_BIG);
    const bf16* oraw = (const bf16*)(C.ws + WS_F + (size_t)RT * 1536 * 2);
    bf16* mix = (bf16*)(C.ws + WS_HN);
    const float* nw = C.in[12];
    const int lane = C.lane;
    for (int r = C.gw; r < RV; r += C.NGW) {
        const int c0 = 8 * lane;
        const bf16x8 ov = *(const bf16x8*)(oraw + (size_t)r * 512 + c0), zv = *(const bf16x8*)(proj + (size_t)r * NIN + 2304 + c0);
        float o[8]; float ss = 0.f;
#pragma unroll
        for (int e = 0; e < 8; ++e) { o[e] = bf2f((unsigned short)ov[e]); ss += o[e] * o[e]; }
        const float rstd = rsqrtf(row16_sum(ss) * (1.0f / 128.0f) + EPS);
        const f32x4 w0 = *(const f32x4*)(nw + (c0 & 127)), w1 = *(const f32x4*)(nw + (c0 & 127) + 4);
        const float wv[8] = {w0.x, w0.y, w0.z, w0.w, w1.x, w1.y, w1.z, w1.w};
        float y[8];
#pragma unroll
        for (int e = 0; e < 8; ++e) y[e] = o[e] * rstd * wv[e] * siluf_(bf2f((unsigned short)zv[e]));
        v4u pk; pk.x = pk2(y[0], y[1]); pk.y = pk2(y[2], y[3]); pk.z = pk2(y[4], y[5]); pk.w = pk2(y[6], y[7]);
        *(v4u*)(mix + (size_t)r * D + 512 + c0) = pk;
    }
}

DI void ph_gla_prep(const Ctx& C) {
    const bf16* hn = (const bf16*)(C.ws + WS_HN);
    const bf16* wgk = (const bf16*)(C.ws + WS_WGK);
    float* glog = (float*)(C.ws + WS_F);
    const float* wup = C.in[15]; const float* bg = C.in[16];
    LAS float* sc = (LAS float*)(C.lds + C.wave * 16384);
    const int lane = C.lane, fr = lane & 15, fq = lane >> 4;
    for (int tile = C.gw; tile < RV / 16; tile += C.NGW) {
        const int r0 = tile * 16;
        f32x4 acc = {0.f, 0.f, 0.f, 0.f};
#pragma unroll 4
        for (int kk = 0; kk < 32; ++kk) {
            const bf16x8 a = *(const bf16x8*)(hn + (size_t)(r0 + fr) * D + kk * 32 + 8 * fq);
            const bf16x8 bb = *(const bf16x8*)(wgk + (size_t)fr * D + kk * 32 + 8 * fq);
            acc = __builtin_amdgcn_mfma_f32_16x16x32_bf16(a, bb, acc, 0, 0, 0);
        }
#pragma unroll
        for (int i = 0; i < 4; ++i) sc[(4 * fq + i) * 16 + fr] = acc[i];
        LDS_WAIT(); asm volatile("" ::: "memory");
        const int c0 = 8 * lane;
        const f32x4 b0 = *(const f32x4*)(bg + c0), b1 = *(const f32x4*)(bg + c0 + 4);
        for (int row = 0; row < 16; ++row) {
            f32x4 a0 = b0, a1 = b1;
#pragma unroll
            for (int j = 0; j < 16; ++j) { const float gk = sc[row * 16 + j];
                a0 += gk * *(const f32x4*)(wup + j * 512 + c0); a1 += gk * *(const f32x4*)(wup + j * 512 + c0 + 4); }
            f32x4 o0, o1;
            o0.x = logsigmoidf_(a0.x) * 0.0625f; o0.y = logsigmoidf_(a0.y) * 0.0625f; o0.z = logsigmoidf_(a0.z) * 0.0625f; o0.w = logsigmoidf_(a0.w) * 0.0625f;
            o1.x = logsigmoidf_(a1.x) * 0.0625f; o1.y = logsigmoidf_(a1.y) * 0.0625f; o1.z = logsigmoidf_(a1.z) * 0.0625f; o1.w = logsigmoidf_(a1.w) * 0.0625f;
            *(f32x4*)(glog + (size_t)(r0 + row) * 512 + c0) = o0; *(f32x4*)(glog + (size_t)(r0 + row) * 512 + c0 + 4) = o1;
        }
        LDS_WAIT(); asm volatile("" ::: "memory");
    }
}

DI void ph_gla_gate(const Ctx& C) {
    const bf16* proj = (const bf16*)(C.ws + WS_BIG);
    const bf16* oraw = (const bf16*)(C.ws + WS_F + (size_t)RT * 512 * 4);
    bf16* mix = (bf16*)(C.ws + WS_HN);
    const float* nw = C.in[17];
    const int lane = C.lane;
    for (int r = C.gw; r < RV; r += C.NGW) {
#pragma unroll
        for (int s = 0; s < 2; ++s) {
            const int c0 = 512 * s + 8 * lane;
            const bf16x8 ov = *(const bf16x8*)(oraw + (size_t)r * D + c0), gv = *(const bf16x8*)(proj + (size_t)r * NIN + 2048 + c0);
            float o[8]; float ss = 0.f;
#pragma unroll
            for (int e = 0; e < 8; ++e) { o[e] = bf2f((unsigned short)ov[e]); ss += o[e] * o[e]; }
            ss = row16_sum(ss); ss += __shfl_xor(ss, 16);
            const float rstd = rsqrtf(ss * (1.0f / 256.0f) + EPS);
            const f32x4 w0 = *(const f32x4*)(nw + (c0 & 255)), w1 = *(const f32x4*)(nw + (c0 & 255) + 4);
            const float wv[8] = {w0.x, w0.y, w0.z, w0.w, w1.x, w1.y, w1.z, w1.w};
            float y[8];
#pragma unroll
            for (int e = 0; e < 8; ++e) y[e] = o[e] * rstd * wv[e] * siluf_(bf2f((unsigned short)gv[e]));
            v4u pk; pk.x = pk2(y[0], y[1]); pk.y = pk2(y[2], y[3]); pk.z = pk2(y[4], y[5]); pk.w = pk2(y[6], y[7]);
            *(v4u*)(mix + (size_t)r * D + c0) = pk;
        }
    }
}
typedef float f32x16 __attribute__((ext_vector_type(16)));
typedef float f32x2_t __attribute__((ext_vector_type(2)));
typedef __bf16 bf16x2_t __attribute__((ext_vector_type(2)));
typedef short s16x4 __attribute__((ext_vector_type(4)));
DI int crow(int r, int h) { return (r & 3) + 8 * (r >> 2) + 4 * h; }
DI unsigned cvtpk(float lo, float hi) { f32x2_t v = {lo, hi}; bf16x2_t b = __builtin_convertvector(v, bf16x2_t); return __builtin_bit_cast(unsigned, b); }
template <int S_> DI bf16x8 pack8(const f32x16& x) {
    v4u p; p.x = cvtpk(x[8 * S_], x[8 * S_ + 1]); p.y = cvtpk(x[8 * S_ + 2], x[8 * S_ + 3]); p.z = cvtpk(x[8 * S_ + 4], x[8 * S_ + 5]); p.w = cvtpk(x[8 * S_ + 6], x[8 * S_ + 7]);
    return __builtin_bit_cast(bf16x8, p);
}
#define MFMA32(a, b, c) __builtin_amdgcn_mfma_f32_32x32x16_bf16((a), (b), (c), 0, 0, 0)
DI bf16x8 ld_perm(const bf16* p) { const v2u a = *(const v2u*)p, b = *(const v2u*)(p + 8); v4u w; w.x = a.x; w.y = a.y; w.z = b.x; w.w = b.y; return __builtin_bit_cast(bf16x8, w); }

constexpr size_t WS_C0 = 243 * MiB;
constexpr size_t WS_C0Q = WS_C0 + 384 * 1024;
constexpr size_t WS_DECAY = 244 * MiB;
constexpr size_t WS_END2 = 245 * MiB;
constexpr int N_CHUNKHEADS = 4 + NBATCH * 64 * 4;
DI int chunkhead_id(int b, int n, int h) { return n == 0 ? h : 4 + ((b * 64 + n - 1) * 4 + h); }

DI void ph_gla_chunk_prep(const Ctx& C) {
    bf16* proj = (bf16*)(C.ws + WS_BIG);
    const float* glog = (const float*)(C.ws + WS_F);
    bf16* attn_all = (bf16*)(C.ws + WS_HN);
    float* decay_all = (float*)(C.ws + WS_DECAY);
    LAS bf16* QD = (LAS bf16*)(C.lds); LAS bf16* KN = (LAS bf16*)(C.lds + 17408); LAS bf16* KDT = (LAS bf16*)(C.lds + 34816); LAS bf16* VT = (LAS bf16*)(C.lds + 53248);
    LAS float* GS = (LAS float*)(C.lds + 90112);
    const int wave = C.wave;
    for (int job = blockIdx.x; job < N_CHUNKHEADS; job += C.G) {
        int t = C.tid; asm volatile("" : "+v"(t));
        const int lane = t & 63;
        int b, n, h; if (job < 4) { b = 0; n = 0; h = job; } else { const int x = job - 4; h = x & 3; n = ((x >> 2) & 63) + 1; b = x >> 8; }
        const int in_row0 = n == 0 ? MR - 48 : b * SEQ + 64 * (n - 1), vfrom = n == 0 ? 48 : 0;
        const bf16* inb = proj + (size_t)in_row0 * NIN;
        bf16* ob = n == 0 ? (bf16*)(C.ws + WS_C0) : proj + (size_t)in_row0 * NIN;
        const float* gb = glog + (size_t)in_row0 * 512 + h * 128;
        const int c = t & 127, rg = t >> 7;
        float g[16]; float ls = 0.f;
#pragma unroll
        for (int rr = 0; rr < 16; ++rr) { const int i = 16 * rg + rr; g[rr] = i >= vfrom ? gb[(size_t)i * 512 + c] : 0.f; ls += g[rr]; }
        GS[rg * 128 + c] = ls;
#pragma unroll
        for (int q = 0; q < 4; ++q) { const int p = t + 512 * q, row = p >> 5, c8 = (p & 31) * 8;
            bf16x8 v = {0, 0, 0, 0, 0, 0, 0, 0}; if (row >= vfrom) v = *(const bf16x8*)(inb + (size_t)row * NIN + 1024 + h * 256 + c8);
#pragma unroll
            for (int e = 0; e < 8; ++e) VT[(c8 + e) * 72 + row] = (bf16)v[e]; }
        __syncthreads();
        float pre = 0.f, tot = 0.f;
#pragma unroll
        for (int gq = 0; gq < 4; ++gq) { const float x = GS[gq * 128 + c]; tot += x; if (gq < rg) pre += x; }
        float run = pre;
#pragma unroll
        for (int rr = 0; rr < 16; ++rr) { const int i = 16 * rg + rr; run += g[rr];
            float qv = 0.f, kv = 0.f; if (i >= vfrom) { qv = bf2f(inb[(size_t)i * NIN + h * 128 + c]); kv = bf2f(inb[(size_t)i * NIN + 512 + h * 128 + c]); }
            QD[i * 136 + c] = (bf16)f2bf(qv * __expf(run) * 0.08838834764831845f);
            KN[i * 136 + c] = (bf16)f2bf(kv * __expf(-run));
            KDT[c * 72 + i] = (bf16)f2bf(kv * __expf(tot - run)); }
        if (rg == 0) decay_all[(size_t)job * 128 + c] = __expf(tot);
        __syncthreads();
#pragma unroll
        for (int q = 0; q < 2; ++q) { const int p = t + 512 * q;
            { const int row = p >> 4, c8 = (p & 15) * 8; *(v4u*)(ob + (size_t)row * NIN + h * 128 + c8) = *(const LAS v4u*)(QD + row * 136 + c8); }
            { const int dk = p >> 3, i8 = (p & 7) * 8; *(v4u*)(ob + (size_t)(dk >> 1) * NIN + 512 + h * 128 + (dk & 1) * 64 + i8) = *(const LAS v4u*)(KDT + dk * 72 + i8); } }
#pragma unroll
        for (int q = 0; q < 4; ++q) { const int p = t + 512 * q, dv = p >> 3, i8 = (p & 7) * 8;
            *(v4u*)(ob + (size_t)(dv >> 2) * NIN + 1024 + h * 256 + (dv & 3) * 64 + i8) = *(const LAS v4u*)(VT + dv * 72 + i8); }
        if (wave < 4) {
            const int ti = wave >> 1, tj = wave & 1, l31 = lane & 31, hh = lane >> 5;
            f32x16 acc;
#pragma unroll
            for (int r = 0; r < 16; ++r) acc[r] = 0.f;
            if (tj <= ti) {
#pragma unroll
                for (int s = 0; s < 8; ++s) { const bf16x8 a = *(const LAS bf16x8*)(QD + (32 * ti + l31) * 136 + 16 * s + 8 * hh), bb = *(const LAS bf16x8*)(KN + (32 * tj + l31) * 136 + 16 * s + 8 * hh);
                    acc = MFMA32(a, bb, acc); }
            }
            bf16* ao = attn_all + (size_t)job * 4096;
#pragma unroll
            for (int r = 0; r < 16; ++r) { const int i = 32 * ti + crow(r, hh), j = 32 * tj + l31; ao[i * 64 + j] = (bf16)f2bf(j <= i ? acc[r] : 0.f); }
        }
        __syncthreads();
    }
}

DI void ph_gla_scan(const Ctx& C) {
    const bf16* proj = (const bf16*)(C.ws + WS_BIG);
    const bf16* attn_all = (const bf16*)(C.ws + WS_HN);
    const float* decay_all = (const float*)(C.ws + WS_DECAY);
    bf16* oraw = (bf16*)(C.ws + WS_F + (size_t)RT * 512 * 4);
    const int lane = C.lane, l31 = lane & 31, hh = lane >> 5, sl = C.wave;
    for (int bh = blockIdx.x; bh < NBATCH * 4; bh += C.G) {
        const int b = bh >> 2, h = bh & 3;
        f32x16 S[4];
#pragma unroll
        for (int t = 0; t < 4; ++t)
#pragma unroll
            for (int r = 0; r < 16; ++r) S[t][r] = 0.f;
        for (int n = 0; n < 65; ++n) {
            const int row0 = b * SEQ + 64 * (n - 1);
            const bf16* ob = n == 0 ? (const bf16*)(C.ws + WS_C0) : proj + (size_t)row0 * NIN;
            const int id = chunkhead_id(b, n, h);
            const bf16* at = attn_all + (size_t)id * 4096; const float* dc = decay_all + (size_t)id * 128;
            const int dv = 32 * sl + l31;
            bf16x8 vB[4];
#pragma unroll
            for (int s = 0; s < 4; ++s) vB[s] = *(const bf16x8*)(ob + (size_t)(dv >> 2) * NIN + 1024 + h * 256 + (dv & 3) * 64 + 16 * s + 8 * hh);
            bf16x8 Sb[4][2];
#pragma unroll
            for (int t = 0; t < 4; ++t) { Sb[t][0] = pack8<0>(S[t]); Sb[t][1] = pack8<1>(S[t]); }
            f32x16 o[2];
#pragma unroll
            for (int mt = 0; mt < 2; ++mt) {
#pragma unroll
                for (int r = 0; r < 16; ++r) o[mt][r] = 0.f;
                const bf16* qrow = ob + (size_t)(32 * mt + l31) * NIN + h * 128 + 4 * hh;
#pragma unroll
                for (int t = 0; t < 4; ++t)
#pragma unroll
                    for (int s = 0; s < 2; ++s) o[mt] = MFMA32(ld_perm(qrow + 32 * t + 16 * s), Sb[t][s], o[mt]);
                const bf16* arow = at + (32 * mt + l31) * 64 + 8 * hh;
#pragma unroll
                for (int s = 0; s < 4; ++s) o[mt] = MFMA32(*(const bf16x8*)(arow + 16 * s), vB[s], o[mt]);
            }
#pragma unroll
            for (int t = 0; t < 4; ++t) {
#pragma unroll
                for (int gq = 0; gq < 4; ++gq) { const f32x4 d4 = *(const f32x4*)(dc + 32 * t + 8 * gq + 4 * hh);
                    S[t][4 * gq] *= d4.x; S[t][4 * gq + 1] *= d4.y; S[t][4 * gq + 2] *= d4.z; S[t][4 * gq + 3] *= d4.w; }
                const int dk = 32 * t + l31;
                const bf16* krow = ob + (size_t)(dk >> 1) * NIN + 512 + h * 128 + (dk & 1) * 64 + 8 * hh;
#pragma unroll
                for (int s = 0; s < 4; ++s) S[t] = MFMA32(*(const bf16x8*)(krow + 16 * s), vB[s], S[t]);
            }
            if (n > 0) {
#pragma unroll
                for (int mt = 0; mt < 2; ++mt)
#pragma unroll
                    for (int r = 0; r < 16; ++r) oraw[(size_t)(row0 + 32 * mt + crow(r, hh)) * D + h * 256 + dv] = (bf16)f2bf(o[mt][r]);
            }
        }
    }
}
DI void ph_dn_chunk_prep(const Ctx& C) {
    bf16* proj = (bf16*)(C.ws + WS_BIG);
    bf16* qkv = (bf16*)(C.ws + WS_F);
    const float* gates = (const float*)(C.ws + WS_GATES);
    float* glast_all = (float*)(C.ws + WS_DECAY);
    LAS bf16* QL = (LAS bf16*)(C.lds); LAS bf16* KL = (LAS bf16*)(C.lds + 17408); LAS bf16* VL = (LAS bf16*)(C.lds + 34816);
    LAS bf16* KDT = (LAS bf16*)(C.lds + 52224); LAS bf16* VBT = (LAS bf16*)(C.lds + 70656);
    LAS float* AM = (LAS float*)(C.lds + 89088);
    LAS float* SC = (LAS float*)(C.lds + 106496);
    const int wave = C.wave;
    for (int job = blockIdx.x; job < N_CHUNKHEADS; job += C.G) {
        int t = C.tid; asm volatile("" : "+v"(t));
        const int lane = t & 63, l31 = lane & 31, hh = lane >> 5;
        int b, n, h; if (job < 4) { b = 0; n = 0; h = job; } else { const int x = job - 4; h = x & 3; n = ((x >> 2) & 63) + 1; b = x >> 8; }
        const int in_row0 = n == 0 ? MR - 48 : b * SEQ + 64 * (n - 1), vfrom = n == 0 ? 48 : 0;
        const bf16* inq = qkv + (size_t)in_row0 * 1536;
        bf16* oq = n == 0 ? (bf16*)(C.ws + WS_C0Q) : qkv + (size_t)in_row0 * 1536;
        bf16* op = n == 0 ? (bf16*)(C.ws + WS_C0) : proj + (size_t)in_row0 * NIN;
#pragma unroll
        for (int q = 0; q < 2; ++q) { const int p = t + 512 * q, row = p >> 4, c8 = (p & 15) * 8;
            v4u vq = {0u, 0u, 0u, 0u}, vk = vq, vv = vq;
            if (row >= vfrom) { const bf16* src = inq + (size_t)row * 1536 + h * 128 + c8; vq = *(const v4u*)src; vk = *(const v4u*)(src + 512); vv = *(const v4u*)(src + 1024); }
            *(LAS v4u*)(QL + row * 136 + c8) = vq; *(LAS v4u*)(KL + row * 136 + c8) = vk; *(LAS v4u*)(VL + row * 136 + c8) = vv; }
        if (wave == 0) {
            float g = 0.f, be = 0.f;
            if (lane >= vfrom) { g = gates[(size_t)(in_row0 + lane) * 16 + 12 + h]; be = gates[(size_t)(in_row0 + lane) * 16 + 8 + h]; }
            float x = g;
#pragma unroll
            for (int o = 1; o < 64; o <<= 1) { const float y = __shfl_up(x, o); if (lane >= o) x += y; }
            const float gl = __int_as_float(__builtin_amdgcn_readlane(__float_as_int(x), 63));
            SC[lane] = x; SC[64 + lane] = be; SC[128 + lane] = __expf(x); SC[192 + lane] = __expf(gl - x);
            if (lane == 0) glast_all[job] = __expf(gl);
        }
        __syncthreads();
        if (wave < 4) {
            const int ti = wave >> 1, tj = wave & 1;
            if (tj > ti) {
#pragma unroll
                for (int r = 0; r < 16; ++r) AM[(32 * ti + crow(r, hh)) * 68 + 32 * tj + l31] = 0.f;
            } else {
                f32x16 aq, ak;
#pragma unroll
                for (int r = 0; r < 16; ++r) { aq[r] = 0.f; ak[r] = 0.f; }
#pragma unroll
                for (int s = 0; s < 8; ++s) {
                    const bf16x8 fq_ = *(const LAS bf16x8*)(QL + (32 * ti + l31) * 136 + 16 * s + 8 * hh), fk_ = *(const LAS bf16x8*)(KL + (32 * ti + l31) * 136 + 16 * s + 8 * hh);
                    const bf16x8 bk_ = *(const LAS bf16x8*)(KL + (32 * tj + l31) * 136 + 16 * s + 8 * hh);
                    aq = MFMA32(fq_, bk_, aq); ak = MFMA32(fk_, bk_, ak);
                }
                const int j = 32 * tj + l31; const float gcj = SC[j];
#pragma unroll
                for (int r = 0; r < 16; ++r) { const int i = 32 * ti + crow(r, hh);
                    const float e = j <= i ? __expf(SC[i] - gcj) : 0.f;
                    op[(size_t)i * NIN + 768 + h * 384 + 192 + j] = (bf16)f2bf(aq[r] * e);
                    AM[i * 68 + j] = j < i ? SC[64 + i] * ak[r] * e : 0.f; }
            }
        } else {
            const int tt = t - 256;
#pragma unroll
            for (int q = 0; q < 4; ++q) { const int p = tt + 256 * q, row = p >> 4, c8 = (p & 15) * 8;
                const bf16x8 q8 = *(const LAS bf16x8*)(QL + row * 136 + c8), k8 = *(const LAS bf16x8*)(KL + row * 136 + c8), v8 = *(const LAS bf16x8*)(VL + row * 136 + c8);
                const float be = SC[64 + row], eg = SC[128 + row], egl = SC[192 + row];
                float qf[8], kf[8];
#pragma unroll
                for (int e = 0; e < 8; ++e) { qf[e] = bf2f((unsigned short)q8[e]) * eg; kf[e] = bf2f((unsigned short)k8[e]);
                    KDT[(c8 + e) * 72 + row] = (bf16)f2bf(kf[e] * egl); VBT[(c8 + e) * 72 + row] = (bf16)f2bf(bf2f((unsigned short)v8[e]) * be); }
                v4u o1; o1.x = pk2(qf[0], qf[1]); o1.y = pk2(qf[2], qf[3]); o1.z = pk2(qf[4], qf[5]); o1.w = pk2(qf[6], qf[7]);
                *(v4u*)(oq + (size_t)row * 1536 + h * 128 + c8) = o1;
                const float nb = -be * eg;
                v4u o2; o2.x = pk2(kf[0] * nb, kf[1] * nb); o2.y = pk2(kf[2] * nb, kf[3] * nb); o2.z = pk2(kf[4] * nb, kf[5] * nb); o2.w = pk2(kf[6] * nb, kf[7] * nb);
                *(v4u*)(op + (size_t)row * NIN + 768 + h * 384 + c8) = o2; }
        }
        __syncthreads();
        if (wave == 0) {
            LAS bf16* TL = QL;
            float tc[64];
            unsigned amb = (unsigned)(uintptr_t)AM + 4u * lane, amu = (unsigned)(uintptr_t)AM; asm volatile("" : "+v"(amb), "+v"(amu));
            const LAS float* AMl = (const LAS float*)amb; const LAS float* AMu = (const LAS float*)amu;
#pragma unroll
            for (int i = 0; i < 64; ++i) {
                float a = AMl[i * 68];
#pragma unroll
                for (int m4 = 0; m4 < i; m4 += 4) { const f32x4 am = *(const LAS f32x4*)(AMu + i * 68 + m4);
                    a += am.x * tc[m4]; if (m4 + 1 < i) a += am.y * tc[m4 + 1]; if (m4 + 2 < i) a += am.z * tc[m4 + 2]; if (m4 + 3 < i) a += am.w * tc[m4 + 3]; }
                tc[i] = -a;
                TL[i * 72 + lane] = (bf16)f2bf(-a);
            }
            LDS_WAIT();
            bf16* tp = op + 768 + h * 384 + 128;
            for (int p = lane; p < 512; p += 64) { const int i = p >> 3, j8 = (p & 7) * 8; v4u w = *(const LAS v4u*)(TL + i * 72 + j8);
                if ((i >> 3) == (p & 7)) { const int e = i & 7; unsigned* wp = (unsigned*)&w; const unsigned one = 0x3f80u;
                    const unsigned x0 = (e >> 1) == 0 ? ((e & 1) ? (w.x & 0xffffu) | (one << 16) : (w.x & 0xffff0000u) | one) : w.x;
                    const unsigned x1 = (e >> 1) == 1 ? ((e & 1) ? (w.y & 0xffffu) | (one << 16) : (w.y & 0xffff0000u) | one) : w.y;
                    const unsigned x2 = (e >> 1) == 2 ? ((e & 1) ? (w.z & 0xffffu) | (one << 16) : (w.z & 0xffff0000u) | one) : w.z;
                    const unsigned x3 = (e >> 1) == 3 ? ((e & 1) ? (w.w & 0xffffu) | (one << 16) : (w.w & 0xffff0000u) | one) : w.w;
                    (void)wp; w.x = x0; w.y = x1; w.z = x2; w.w = x3; }
                *(v4u*)(tp + (size_t)i * NIN + j8) = w; }
        } else {
            for (int p = t - 64; p < 2048; p += 448) { const int which = p >> 10, pp = p & 1023, dd = pp >> 3, i8 = (pp & 7) * 8;
                const v4u v = *(const LAS v4u*)((which ? VBT : KDT) + dd * 72 + i8);
                *(v4u*)(oq + (size_t)(dd >> 1) * 1536 + 512 + which * 512 + h * 128 + (dd & 1) * 64 + i8) = v; }
        }
        __syncthreads();
    }
}

DI void cvt4(f32x16& x, int g, v2u w) { x[4 * g] = bflo(w.x); x[4 * g + 1] = bfhi(w.x); x[4 * g + 2] = bflo(w.y); x[4 * g + 3] = bfhi(w.y); }
DI void ph_dn_scan(const Ctx& C) {
    const bf16* proj = (const bf16*)(C.ws + WS_BIG);
    const bf16* qkv = (const bf16*)(C.ws + WS_F);
    const float* glast_all = (const float*)(C.ws + WS_DECAY);
    bf16* oraw = (bf16*)(C.ws + WS_F + (size_t)RT * 1536 * 2);
    const int lane = C.lane, l31 = lane & 31, hh = lane >> 5, sl = C.wave & 3;
    for (int bh = blockIdx.x * 2 + (C.wave >> 2); bh < NBATCH * 4; bh += C.G * 2) {
        const int b = bh >> 2, h = bh & 3;
        f32x16 S[4];
#pragma unroll
        for (int t = 0; t < 4; ++t)
#pragma unroll
            for (int r = 0; r < 16; ++r) S[t][r] = 0.f;
        const int dv = 32 * sl + l31;
        for (int n = 0; n < 65; ++n) {
            const int row0 = b * SEQ + 64 * (n - 1);
            const bf16* oq = n == 0 ? (const bf16*)(C.ws + WS_C0Q) : qkv + (size_t)row0 * 1536;
            const bf16* op = (n == 0 ? (const bf16*)(C.ws + WS_C0) : proj + (size_t)row0 * NIN) + 768 + h * 384;
            const float glast = glast_all[chunkhead_id(b, n, h)];
            bf16x8 Sb[4][2];
#pragma unroll
            for (int t = 0; t < 4; ++t) { Sb[t][0] = pack8<0>(S[t]); Sb[t][1] = pack8<1>(S[t]); }
            f32x16 X[2];
            const bf16* vrow = oq + (size_t)(dv >> 1) * 1536 + 1024 + h * 128 + (dv & 1) * 64 + 4 * hh;
#pragma unroll
            for (int mt = 0; mt < 2; ++mt) {
#pragma unroll
                for (int g = 0; g < 4; ++g) cvt4(X[mt], g, *(const v2u*)(vrow + 32 * mt + 8 * g));
                const bf16* krow = op + (size_t)(32 * mt + l31) * NIN + 4 * hh;
#pragma unroll
                for (int t = 0; t < 4; ++t)
#pragma unroll
                    for (int s = 0; s < 2; ++s) X[mt] = MFMA32(ld_perm(krow + 32 * t + 16 * s), Sb[t][s], X[mt]);
            }
            f32x16 o[2];
#pragma unroll
            for (int mt = 0; mt < 2; ++mt) {
#pragma unroll
                for (int r = 0; r < 16; ++r) o[mt][r] = 0.f;
                const bf16* qrow = oq + (size_t)(32 * mt + l31) * 1536 + h * 128 + 4 * hh;
#pragma unroll
                for (int t = 0; t < 4; ++t)
#pragma unroll
                    for (int s = 0; s < 2; ++s) o[mt] = MFMA32(ld_perm(qrow + 32 * t + 16 * s), Sb[t][s], o[mt]);
            }
            bf16x8 Xb[2][2];
#pragma unroll
            for (int mt = 0; mt < 2; ++mt) { Xb[mt][0] = pack8<0>(X[mt]); Xb[mt][1] = pack8<1>(X[mt]); }
            f32x16 V[2];
#pragma unroll
            for (int mt = 0; mt < 2; ++mt) {
#pragma unroll
                for (int r = 0; r < 16; ++r) V[mt][r] = 0.f;
                const bf16* trow = op + (size_t)(32 * mt + l31) * NIN + 128 + 4 * hh;
#pragma unroll
                for (int mx = 0; mx < 2; ++mx) if (mx <= mt) {
#pragma unroll
                    for (int s = 0; s < 2; ++s) V[mt] = MFMA32(ld_perm(trow + 32 * mx + 16 * s), Xb[mx][s], V[mt]); }
            }
            bf16x8 Vb[2][2];
#pragma unroll
            for (int mt = 0; mt < 2; ++mt) { Vb[mt][0] = pack8<0>(V[mt]); Vb[mt][1] = pack8<1>(V[mt]); }
#pragma unroll
            for (int mt = 0; mt < 2; ++mt) {
                const bf16* arow = op + (size_t)(32 * mt + l31) * NIN + 192 + 4 * hh;
#pragma unroll
                for (int mx = 0; mx < 2; ++mx) if (mx <= mt) {
#pragma unroll
                    for (int s = 0; s < 2; ++s) o[mt] = MFMA32(ld_perm(arow + 32 * mx + 16 * s), Vb[mx][s], o[mt]); }
            }
#pragma unroll
            for (int t = 0; t < 4; ++t) {
#pragma unroll
                for (int r = 0; r < 16; ++r) S[t][r] *= glast;
                const int dk = 32 * t + l31;
                const bf16* kd = oq + (size_t)(dk >> 1) * 1536 + 512 + h * 128 + (dk & 1) * 64 + 4 * hh;
#pragma unroll
                for (int mx = 0; mx < 2; ++mx)
#pragma unroll
                    for (int s = 0; s < 2; ++s) S[t] = MFMA32(ld_perm(kd + 32 * mx + 16 * s), Vb[mx][s], S[t]);
            }
            if (n > 0 || b == 0) {
#pragma unroll
                for (int mt = 0; mt < 2; ++mt)
#pragma unroll
                    for (int r = 0; r < 16; ++r) { const int i = 32 * mt + crow(r, hh);
                        if (n > 0) oraw[(size_t)(row0 + i) * 512 + h * 128 + dv] = (bf16)f2bf(o[mt][r]);
                        else if (i >= 48) oraw[(size_t)(MR + i - 48) * 512 + h * 128 + dv] = (bf16)f2bf(o[mt][r]); }
            }
        }
    }
}
DI void ph_swa(const Ctx& C) {
    const bf16* proj = (const bf16*)(C.ws + WS_BIG);
    bf16* mix = (bf16*)(C.ws + WS_HN);
    const float* table = C.in[6]; const float* sinks = C.in[9];
    LAS bf16* KL = (LAS bf16*)(C.lds); LAS bf16* VT = (LAS bf16*)(C.lds + 32256); LAS float* BT = (LAS float*)(C.lds + 61952);
    const int wave = C.wave;
    const float NEG = -1e30f;
    for (int unit = blockIdx.x; unit < NBATCH * 64 * 2; unit += C.G) {
        int t = C.tid; asm volatile("" : "+v"(t));
        const int lane = t & 63, l31 = lane & 31, hh = lane >> 5;
        const int kvh = unit & 1, qb = (unit >> 1) & 63, b = unit >> 7, q0 = qb * 64;
        for (int p = t; p < 224 * 8; p += NTHREADS) { const int ks = p >> 3, c8 = (p & 7) * 8;
            int row = -1; if (ks < 192) { const int tk = q0 - 128 + ks; if (tk >= 0) row = b * SEQ + tk; } else if (ks < 208) row = MR + ks - 192;
            v4u kk = {0u, 0u, 0u, 0u}, vv = kk;
            if (row >= 0) { kk = *(const v4u*)(proj + (size_t)row * NIN + 512 + kvh * 64 + c8); vv = *(const v4u*)(proj + (size_t)row * NIN + 640 + kvh * 64 + c8); }
            *(LAS v4u*)(KL + ks * 72 + c8) = kk;
            VT[(c8 + 0) * 232 + ks] = (bf16)(vv.x & 0xffffu); VT[(c8 + 1) * 232 + ks] = (bf16)(vv.x >> 16); VT[(c8 + 2) * 232 + ks] = (bf16)(vv.y & 0xffffu); VT[(c8 + 3) * 232 + ks] = (bf16)(vv.y >> 16);
            VT[(c8 + 4) * 232 + ks] = (bf16)(vv.z & 0xffffu); VT[(c8 + 5) * 232 + ks] = (bf16)(vv.z >> 16); VT[(c8 + 6) * 232 + ks] = (bf16)(vv.w & 0xffffu); VT[(c8 + 7) * 232 + ks] = (bf16)(vv.w >> 16); }
        for (int p = t; p < 4 * 129; p += NTHREADS) { const int gi = p / 129, rel = p % 129; BT[gi * 132 + rel] = table[t5_bucket(rel) * 8 + kvh * 4 + gi]; }
        __syncthreads();
        {
            const int qs = wave >> 2, gi = wave & 3, hq = kvh * 4 + gi;
            const int tq = q0 + 32 * qs + l31; const size_t rowq = (size_t)(b * SEQ + tq);
            bf16x8 qf[4];
#pragma unroll
            for (int s = 0; s < 4; ++s) qf[s] = *(const bf16x8*)(proj + rowq * NIN + hq * 64 + 16 * s + 8 * hh);
            f32x16 P[6];
#pragma unroll
            for (int j = 0; j < 6; ++j) {
                const int kt = j < 5 ? qs + j : 6;
                f32x16 acc;
#pragma unroll
                for (int r = 0; r < 16; ++r) acc[r] = 0.f;
#pragma unroll
                for (int s = 0; s < 4; ++s) acc = MFMA32(*(const LAS bf16x8*)(KL + (32 * kt + l31) * 72 + 16 * s + 8 * hh), qf[s], acc);
                P[j] = acc;
            }
            float mx = sinks[hq];
#pragma unroll
            for (int j = 0; j < 5; ++j)
#pragma unroll
                for (int r = 0; r < 16; ++r) { const int tk = q0 - 128 + 32 * (qs + j) + crow(r, hh), rel = tq - tk;
                    const bool ok = tk >= 0 && rel >= 0 && rel < 128;
                    const float v = ok ? P[j][r] * 0.125f + BT[gi * 132 + (ok ? rel : 0)] : NEG; P[j][r] = v; mx = fmaxf(mx, v); }
#pragma unroll
            for (int r = 0; r < 16; ++r) { const int m = crow(r, hh); const bool ok = m < NMETA; int relm = NMETA + tq - m; relm = relm > 128 ? 128 : relm;
                const float v = ok ? P[5][r] * 0.125f + BT[gi * 132 + relm] : NEG; P[5][r] = v; mx = fmaxf(mx, v); }
            mx = fmaxf(mx, __shfl_xor(mx, 32));
            float sum = 0.f;
#pragma unroll
            for (int j = 0; j < 6; ++j)
#pragma unroll
                for (int r = 0; r < 16; ++r) { const float e = __expf(P[j][r] - mx); P[j][r] = e; sum += e; }
            sum += __shfl_xor(sum, 32);
            const float inv = 1.0f / (sum + __expf(sinks[hq] - mx));
            f32x16 O[2];
#pragma unroll
            for (int dt = 0; dt < 2; ++dt)
#pragma unroll
                for (int r = 0; r < 16; ++r) O[dt][r] = 0.f;
#pragma unroll
            for (int j = 0; j < 6; ++j) {
                const int kt = j < 5 ? qs + j : 6;
                const bf16x8 p0 = pack8<0>(P[j]), p1 = pack8<1>(P[j]);
#pragma unroll
                for (int dt = 0; dt < 2; ++dt) {
                    const LAS bf16* vr = VT + (32 * dt + l31) * 232 + 32 * kt + 4 * hh;
                    const v2u a0 = *(const LAS v2u*)vr, a1 = *(const LAS v2u*)(vr + 8), a2 = *(const LAS v2u*)(vr + 16), a3 = *(const LAS v2u*)(vr + 24);
                    v4u w0; w0.x = a0.x; w0.y = a0.y; w0.z = a1.x; w0.w = a1.y; v4u w1; w1.x = a2.x; w1.y = a2.y; w1.z = a3.x; w1.w = a3.y;
                    O[dt] = MFMA32(__builtin_bit_cast(bf16x8, w0), p0, O[dt]); O[dt] = MFMA32(__builtin_bit_cast(bf16x8, w1), p1, O[dt]);
                }
            }
            bf16* orow = mix + rowq * D + hq * 64 + 4 * hh;
#pragma unroll
            for (int dt = 0; dt < 2; ++dt)
#pragma unroll
                for (int g = 0; g < 4; ++g) { v2u w; w.x = pk2(O[dt][4 * g] * inv, O[dt][4 * g + 1] * inv); w.y = pk2(O[dt][4 * g + 2] * inv, O[dt][4 * g + 3] * inv);
                    *(v2u*)(orow + 32 * dt + 8 * g) = w; }
        }
        __syncthreads();
    }
}
DI void ph_swa_meta(const Ctx& C) {
    const bf16* proj = (const bf16*)(C.ws + WS_BIG);
    bf16* mix = (bf16*)(C.ws + WS_HN);
    const float* table = C.in[6]; const float* sinks = C.in[9];
    const int lane = C.lane, qi = lane & 15, part = lane >> 4;
    if (C.gw < 8) {
        const int hq = C.gw, kvh = hq >> 2;
        const bf16* qp = proj + (size_t)(MR + qi) * NIN + hq * 64 + part * 16;
        const bf16x8 q0 = *(const bf16x8*)qp, q1 = *(const bf16x8*)(qp + 8);
        float s[16];
#pragma unroll
        for (int m = 0; m < 16; ++m) { const bf16* kp = proj + (size_t)(MR + m) * NIN + 512 + kvh * 64 + part * 16;
            const bf16x8 k0 = *(const bf16x8*)kp, k1 = *(const bf16x8*)(kp + 8); float a = 0.f;
#pragma unroll
            for (int e = 0; e < 8; ++e) a += bf2f((unsigned short)q0[e]) * bf2f((unsigned short)k0[e]) + bf2f((unsigned short)q1[e]) * bf2f((unsigned short)k1[e]);
            a += __shfl_xor(a, 16); a += __shfl_xor(a, 32);
            s[m] = m <= qi ? a * 0.125f + table[t5_bucket(qi - m < 0 ? 0 : qi - m) * 8 + hq] : -1e30f; }
        float mx = sinks[hq];
#pragma unroll
        for (int m = 0; m < 16; ++m) mx = fmaxf(mx, s[m]);
        float den = __expf(sinks[hq] - mx);
#pragma unroll
        for (int m = 0; m < 16; ++m) { s[m] = __expf(s[m] - mx); den += s[m]; }
        const float inv = 1.0f / den;
        float o[16];
#pragma unroll
        for (int e = 0; e < 16; ++e) o[e] = 0.f;
#pragma unroll
        for (int m = 0; m < 16; ++m) { const bf16* vp = proj + (size_t)(MR + m) * NIN + 640 + kvh * 64 + part * 16;
            const bf16x8 v0 = *(const bf16x8*)vp, v1 = *(const bf16x8*)(vp + 8);
#pragma unroll
            for (int e = 0; e < 8; ++e) { o[e] += s[m] * bf2f((unsigned short)v0[e]); o[8 + e] += s[m] * bf2f((unsigned short)v1[e]); } }
        v4u w0, w1; w0.x = pk2(o[0] * inv, o[1] * inv); w0.y = pk2(o[2] * inv, o[3] * inv); w0.z = pk2(o[4] * inv, o[5] * inv); w0.w = pk2(o[6] * inv, o[7] * inv);
        w1.x = pk2(o[8] * inv, o[9] * inv); w1.y = pk2(o[10] * inv, o[11] * inv); w1.z = pk2(o[12] * inv, o[13] * inv); w1.w = pk2(o[14] * inv, o[15] * inv);
        bf16* op = mix + (size_t)(MR + qi) * D + hq * 64 + part * 16;
        *(v4u*)op = w0; *(v4u*)(op + 8) = w1;
    }
}
DI bf16x8 ld_perm_l(const LAS bf16* p) { const v2u a = *(const LAS v2u*)p, b = *(const LAS v2u*)(p + 8); v4u w; w.x = a.x; w.y = a.y; w.z = b.x; w.w = b.y; return __builtin_bit_cast(bf16x8, w); }

DI void ph_dn_scan2(const Ctx& C) {
    const bf16* proj = (const bf16*)(C.ws + WS_BIG);
    const bf16* qkv = (const bf16*)(C.ws + WS_F);
    const float* glast_all = (const float*)(C.ws + WS_DECAY);
    bf16* oraw = (bf16*)(C.ws + WS_F + (size_t)RT * 1536 * 2);
    LAS bf16* NK = (LAS bf16*)(C.lds); LAS bf16* QD = (LAS bf16*)(C.lds + 17408); LAS bf16* TL = (LAS bf16*)(C.lds + 34816); LAS bf16* AT = (LAS bf16*)(C.lds + 44032);
    LAS bf16* KD = (LAS bf16*)(C.lds + 53248); LAS bf16* VB = (LAS bf16*)(C.lds + 71680);
    const int lane = C.lane, l31 = lane & 31, hh = lane >> 5, wave = C.wave, t_ = C.tid;
    for (int bh = blockIdx.x; bh < NBATCH * 4; bh += C.G) {
        const int b = bh >> 2, h = bh & 3;
        v4u R[5];
#define DN_BASES(n_) const int n__ = (n_); const int r0__ = b * SEQ + 64 * (n__ - 1); \
            const bf16* oq__ = n__ == 0 ? (const bf16*)(C.ws + WS_C0Q) : qkv + (size_t)r0__ * 1536; \
            const bf16* op__ = (n__ == 0 ? (const bf16*)(C.ws + WS_C0) : proj + (size_t)r0__ * NIN) + 768 + h * 384;
#define DN_LOAD_A(n_) do { DN_BASES(n_) \
            _Pragma("unroll") for (int q = 0; q < 2; ++q) { const int p = t_ + 512 * q, row = p >> 4, c8 = (p & 15) * 8; R[q] = *(const v4u*)(op__ + (size_t)row * NIN + c8); \
                const int dd = p >> 3, i8 = (p & 7) * 8; R[2 + q] = *(const v4u*)(oq__ + (size_t)(dd >> 1) * 1536 + 1024 + h * 128 + (dd & 1) * 64 + i8); } \
            { const int row = t_ >> 3, c8 = (t_ & 7) * 8; R[4] = *(const v4u*)(op__ + (size_t)row * NIN + 128 + c8); } } while (0)
#define DN_WRITE_A() do { \
            _Pragma("unroll") for (int q = 0; q < 2; ++q) { const int p = t_ + 512 * q, row = p >> 4, c8 = (p & 15) * 8; *(LAS v4u*)(NK + row * 136 + c8) = R[q]; \
                const int dd = p >> 3, i8 = (p & 7) * 8; *(LAS v4u*)(VB + dd * 72 + i8) = R[2 + q]; } \
            { const int row = t_ >> 3, c8 = (t_ & 7) * 8; *(LAS v4u*)(TL + row * 72 + c8) = R[4]; } } while (0)
#define DN_LOAD_B(n_) do { DN_BASES(n_) \
            _Pragma("unroll") for (int q = 0; q < 2; ++q) { const int p = t_ + 512 * q, row = p >> 4, c8 = (p & 15) * 8; R[q] = *(const v4u*)(oq__ + (size_t)row * 1536 + h * 128 + c8); \
                const int dd = p >> 3, i8 = (p & 7) * 8; R[2 + q] = *(const v4u*)(oq__ + (size_t)(dd >> 1) * 1536 + 512 + h * 128 + (dd & 1) * 64 + i8); } \
            { const int row = t_ >> 3, c8 = (t_ & 7) * 8; R[4] = *(const v4u*)(op__ + (size_t)row * NIN + 192 + c8); } } while (0)
#define DN_WRITE_B() do { \
            _Pragma("unroll") for (int q = 0; q < 2; ++q) { const int p = t_ + 512 * q, row = p >> 4, c8 = (p & 15) * 8; *(LAS v4u*)(QD + row * 136 + c8) = R[q]; \
                const int dd = p >> 3, i8 = (p & 7) * 8; *(LAS v4u*)(KD + dd * 72 + i8) = R[2 + q]; } \
            { const int row = t_ >> 3, c8 = (t_ & 7) * 8; *(LAS v4u*)(AT + row * 72 + c8) = R[4]; } } while (0)
        DN_LOAD_A(0); DN_WRITE_A(); DN_LOAD_B(0); DN_WRITE_B();
        __syncthreads();
        f32x16 S[4];
#pragma unroll
        for (int t = 0; t < 4; ++t)
#pragma unroll
            for (int r = 0; r < 16; ++r) S[t][r] = 0.f;
        const int dv = 32 * (wave & 3) + l31;
        for (int n = 0; n < 65; ++n) {
            const int row0 = b * SEQ + 64 * (n - 1);
            if (n < 64) DN_LOAD_A(n + 1);
            f32x16 o[2]; bf16x8 Vb[2][2];
            if (wave < 4) {
                bf16x8 Sb[4][2];
#pragma unroll
                for (int t = 0; t < 4; ++t) { Sb[t][0] = pack8<0>(S[t]); Sb[t][1] = pack8<1>(S[t]); }
                f32x16 X[2];
#pragma unroll
                for (int mt = 0; mt < 2; ++mt) {
#pragma unroll
                    for (int g = 0; g < 4; ++g) cvt4(X[mt], g, *(const LAS v2u*)(VB + dv * 72 + 32 * mt + 8 * g + 4 * hh));
                    const LAS bf16* krow = NK + (32 * mt + l31) * 136 + 4 * hh;
#pragma unroll
                    for (int t = 0; t < 4; ++t)
#pragma unroll
                        for (int s = 0; s < 2; ++s) X[mt] = MFMA32(ld_perm_l(krow + 32 * t + 16 * s), Sb[t][s], X[mt]);
                }
                bf16x8 Xb[2][2];
#pragma unroll
                for (int mt = 0; mt < 2; ++mt) { Xb[mt][0] = pack8<0>(X[mt]); Xb[mt][1] = pack8<1>(X[mt]); }
                f32x16 V[2];
#pragma unroll
                for (int mt = 0; mt < 2; ++mt) {
#pragma unroll
                    for (int r = 0; r < 16; ++r) V[mt][r] = 0.f;
                    const LAS bf16* trow = TL + (32 * mt + l31) * 72 + 4 * hh;
#pragma unroll
                    for (int mx = 0; mx < 2; ++mx) if (mx <= mt) {
#pragma unroll
                        for (int s = 0; s < 2; ++s) V[mt] = MFMA32(ld_perm_l(trow + 32 * mx + 16 * s), Xb[mx][s], V[mt]); }
                }
#pragma unroll
                for (int mt = 0; mt < 2; ++mt) { Vb[mt][0] = pack8<0>(V[mt]); Vb[mt][1] = pack8<1>(V[mt]); }
            }
            __syncthreads();
            if (n < 64) { DN_WRITE_A(); DN_LOAD_B(n + 1); }
            if (wave < 4) {
                const float glast = glast_all[chunkhead_id(b, n, h)];
                bf16x8 Sb[4][2];
#pragma unroll
                for (int t = 0; t < 4; ++t) { Sb[t][0] = pack8<0>(S[t]); Sb[t][1] = pack8<1>(S[t]); }
#pragma unroll
                for (int mt = 0; mt < 2; ++mt) {
#pragma unroll
                    for (int r = 0; r < 16; ++r) o[mt][r] = 0.f;
                    const LAS bf16* qrow = QD + (32 * mt + l31) * 136 + 4 * hh;
#pragma unroll
                    for (int t = 0; t < 4; ++t)
#pragma unroll
                        for (int s = 0; s < 2; ++s) o[mt] = MFMA32(ld_perm_l(qrow + 32 * t + 16 * s), Sb[t][s], o[mt]);
                    const LAS bf16* arow = AT + (32 * mt + l31) * 72 + 4 * hh;
#pragma unroll
                    for (int mx = 0; mx < 2; ++mx) if (mx <= mt) {
#pragma unroll
                        for (int s = 0; s < 2; ++s) o[mt] = MFMA32(ld_perm_l(arow + 32 * mx + 16 * s), Vb[mx][s], o[mt]); }
                }
#pragma unroll
                for (int t = 0; t < 4; ++t) {
#pragma unroll
                    for (int r = 0; r < 16; ++r) S[t][r] *= glast;
                    const LAS bf16* kd = KD + (32 * t + l31) * 72 + 4 * hh;
#pragma unroll
                    for (int mx = 0; mx < 2; ++mx)
#pragma unroll
                        for (int s = 0; s < 2; ++s) S[t] = MFMA32(ld_perm_l(kd + 32 * mx + 16 * s), Vb[mx][s], S[t]);
                }
                if (n > 0 || b == 0) {
#pragma unroll
                    for (int mt = 0; mt < 2; ++mt)
#pragma unroll
                        for (int r = 0; r < 16; ++r) { const int i = 32 * mt + crow(r, hh);
                            if (n > 0) oraw[(size_t)(row0 + i) * 512 + h * 128 + dv] = (bf16)f2bf(o[mt][r]);
                            else if (i >= 48) oraw[(size_t)(MR + i - 48) * 512 + h * 128 + dv] = (bf16)f2bf(o[mt][r]); }
                }
            }
            __syncthreads();
            if (n < 64) DN_WRITE_B();
        }
        __syncthreads();
#undef DN_BASES
#undef DN_LOAD_A
#undef DN_WRITE_A
#undef DN_LOAD_B
#undef DN_WRITE_B
    }
}

DI void ph_gla_scan2(const Ctx& C) {
    const bf16* proj = (const bf16*)(C.ws + WS_BIG);
    const bf16* attn_all = (const bf16*)(C.ws + WS_HN);
    const float* decay_all = (const float*)(C.ws + WS_DECAY);
    bf16* oraw = (bf16*)(C.ws + WS_F + (size_t)RT * 512 * 4);
    LAS bf16* QD = (LAS bf16*)(C.lds); LAS bf16* KD = (LAS bf16*)(C.lds + 17408); LAS bf16* AT = (LAS bf16*)(C.lds + 35840); LAS bf16* VT = (LAS bf16*)(C.lds + 45056);
    LAS float* DC = (LAS float*)(C.lds + 81920);
    const int lane = C.lane, l31 = lane & 31, hh = lane >> 5, t_ = C.tid;
    for (int bh = blockIdx.x; bh < NBATCH * 4; bh += C.G) {
        const int b = bh >> 2, h = bh & 3;
        v4u R[9]; float Rd = 0.f;
#define GL_LOAD(n_) do { const int n__ = (n_); const int r0__ = b * SEQ + 64 * (n__ - 1); const int id__ = chunkhead_id(b, n__, h); \
            const bf16* ob__ = n__ == 0 ? (const bf16*)(C.ws + WS_C0) : proj + (size_t)r0__ * NIN; \
            _Pragma("unroll") for (int q = 0; q < 2; ++q) { const int p = t_ + 512 * q, row = p >> 4, c8 = (p & 15) * 8; \
                R[q] = *(const v4u*)(ob__ + (size_t)row * NIN + h * 128 + c8); \
                const int dk = p >> 3, i8 = (p & 7) * 8; R[2 + q] = *(const v4u*)(ob__ + (size_t)(dk >> 1) * NIN + 512 + h * 128 + (dk & 1) * 64 + i8); } \
            R[4] = *(const v4u*)(attn_all + (size_t)id__ * 4096 + t_ * 8); \
            _Pragma("unroll") for (int q = 0; q < 4; ++q) { const int p = t_ + 512 * q, dvv = p >> 3, i8 = (p & 7) * 8; \
                R[5 + q] = *(const v4u*)(ob__ + (size_t)(dvv >> 2) * NIN + 1024 + h * 256 + (dvv & 3) * 64 + i8); } \
            if (t_ < 128) Rd = decay_all[(size_t)id__ * 128 + t_]; } while (0)
#define GL_WRITE() do { \
            _Pragma("unroll") for (int q = 0; q < 2; ++q) { const int p = t_ + 512 * q, row = p >> 4, c8 = (p & 15) * 8; \
                *(LAS v4u*)(QD + row * 136 + c8) = R[q]; const int dk = p >> 3, i8 = (p & 7) * 8; *(LAS v4u*)(KD + dk * 72 + i8) = R[2 + q]; } \
            { const int row = t_ >> 3, c8 = (t_ & 7) * 8; *(LAS v4u*)(AT + row * 72 + c8) = R[4]; } \
            _Pragma("unroll") for (int q = 0; q < 4; ++q) { const int p = t_ + 512 * q, dvv = p >> 3, i8 = (p & 7) * 8; *(LAS v4u*)(VT + dvv * 72 + i8) = R[5 + q]; } \
            if (t_ < 128) DC[t_] = Rd; } while (0)
        GL_LOAD(0); GL_WRITE();
        __syncthreads();
        f32x16 S[4];
#pragma unroll
        for (int t = 0; t < 4; ++t)
#pragma unroll
            for (int r = 0; r < 16; ++r) S[t][r] = 0.f;
        const int dv = 32 * C.wave + l31;
        for (int n = 0; n < 65; ++n) {
            if (n < 64) GL_LOAD(n + 1);
            const int row0 = b * SEQ + 64 * (n - 1);
            bf16x8 vB[4];
#pragma unroll
            for (int s = 0; s < 4; ++s) vB[s] = *(const LAS bf16x8*)(VT + dv * 72 + 16 * s + 8 * hh);
            bf16x8 Sb[4][2];
#pragma unroll
            for (int t = 0; t < 4; ++t) { Sb[t][0] = pack8<0>(S[t]); Sb[t][1] = pack8<1>(S[t]); }
            f32x16 o[2];
#pragma unroll
            for (int mt = 0; mt < 2; ++mt) {
#pragma unroll
                for (int r = 0; r < 16; ++r) o[mt][r] = 0.f;
                const LAS bf16* qrow = QD + (32 * mt + l31) * 136 + 4 * hh;
#pragma unroll
                for (int t = 0; t < 4; ++t)
#pragma unroll
                    for (int s = 0; s < 2; ++s) o[mt] = MFMA32(ld_perm_l(qrow + 32 * t + 16 * s), Sb[t][s], o[mt]);
                const LAS bf16* arow = AT + (32 * mt + l31) * 72 + 8 * hh;
#pragma unroll
                for (int s = 0; s < 4; ++s) o[mt] = MFMA32(*(const LAS bf16x8*)(arow + 16 * s), vB[s], o[mt]);
            }
#pragma unroll
            for (int t = 0; t < 4; ++t) {
#pragma unroll
                for (int gq = 0; gq < 4; ++gq) { const f32x4 d4 = *(const LAS f32x4*)(DC + 32 * t + 8 * gq + 4 * hh);
                    S[t][4 * gq] *= d4.x; S[t][4 * gq + 1] *= d4.y; S[t][4 * gq + 2] *= d4.z; S[t][4 * gq + 3] *= d4.w; }
                const LAS bf16* krow = KD + (32 * t + l31) * 72 + 8 * hh;
#pragma unroll
                for (int s = 0; s < 4; ++s) S[t] = MFMA32(*(const LAS bf16x8*)(krow + 16 * s), vB[s], S[t]);
            }
            if (n > 0) {
#pragma unroll
                for (int mt = 0; mt < 2; ++mt)
#pragma unroll
                    for (int r = 0; r < 16; ++r) oraw[(size_t)(row0 + 32 * mt + crow(r, hh)) * D + h * 256 + dv] = (bf16)f2bf(o[mt][r]);
            }
            __syncthreads();
            if (n < 64) GL_WRITE();
            __syncthreads();
        }
#undef GL_LOAD
#undef GL_WRITE
    }
}
struct Args { const float* in[19]; float* out; unsigned char* ws; int ph_lo, ph_hi; };
static_assert(sizeof(Args) == 19 * 8 + 8 + 8 + 8, "Args has no padding");
constexpr int CW_BAR = 4096;

template <int N, int K, class Epi>
DI void run_gemm(const Ctx& C, const bf16* A, const bf16* Bt, const Epi& E) {
    pg8::Gemm g{A, Bt, RT, N, K}; pg8::StaticOrder S; S.init(RT, N, C.G, (int)blockIdx.x);
    pg8::gemm_phase<Epi, pg8::StaticOrder, true, true>(C.lds, g, S, E);
}

__global__ void __launch_bounds__(NTHREADS, 2) mk_fwd(Args args) {
    extern __shared__ __attribute__((aligned(16))) unsigned char lds_raw[];
    Ctx C;
    C.lds = (LAS unsigned char*)lds_raw;
    C.tid = threadIdx.x; C.lane = C.tid & 63; C.wave = __builtin_amdgcn_readfirstlane(C.tid >> 6);
    C.G = gridDim.x; C.gw = blockIdx.x * NWAVES + C.wave; C.NGW = C.G * NWAVES;
#pragma unroll
    for (int i = 0; i < 19; ++i) C.in[i] = args.in[i];
    C.out = args.out; C.ws = args.ws;
    unsigned char* const ws = args.ws;
    for (int u = C.tid; u < (LDS_BYTES - LDSCTL_OFF) / 4; u += NTHREADS) ((LAS unsigned*)(C.lds + LDSCTL_OFF))[u] = 0u;
    __syncthreads();
#if MK_ONE_LAUNCH
    XcdBarrier bar = xcd_barrier_post((unsigned*)(ws + WS_CTL) + CW_BAR, (volatile LAS unsigned*)(C.lds + MISC_OFF) + 8);
#define SEAM(k) do { if (IN((k) + 1)) xcd_barrier(bar); } while (0)
#else
#define SEAM(k) do { } while (0)
#endif
    const int lo = args.ph_lo, hi = args.ph_hi;
#define IN(k) (lo <= (k) && (k) < hi)
#define HN_ ((bf16*)(ws + WS_HN))
#define BIG_ ((bf16*)(ws + WS_BIG))
#define F_ ((float*)(ws + WS_F))
    if (IN(0)) { ph_prologue(C); SEAM(0); }
#define FFN_PHASES(P, L, WGU, WDN, WHICH, CONV) \
    if (IN(P)) { pg8::EpiSwiGLU E{BIG_, FF}; run_gemm<2 * FF, D>(C, HN_, (const bf16*)(ws + (WGU)), E); SEAM(P); } \
    if (IN(P + 1)) { pg8::EpiF32 E{F_, D}; run_gemm<D, FF>(C, BIG_, (const bf16*)(ws + (WDN)), E); SEAM(P + 1); } \
    if (IN(P + 2)) { ph_rownorm(C, L, WHICH); if (CONV) convert_weights(C, 1); SEAM(P + 2); }
    FFN_PHASES(1, 0, WS_WGU_A, WS_WDN_A, 0, false)
    if (IN(4)) { pg8::EpiProj E{BIG_, NIN, (float*)(ws + WS_GATES), 11}; run_gemm<NIN, D>(C, HN_, (const bf16*)(ws + WS_WIN), E); SEAM(4); }
    if (IN(5)) { ph_dn_prep(C); ph_swa(C); ph_swa_meta(C); SEAM(5); }
    if (IN(6)) { ph_dn_chunk_prep(C); xcd_barrier(bar); ph_dn_scan2(C); SEAM(6); }
    if (IN(7)) { ph_dn_gate(C); SEAM(7); }
    if (IN(8)) { pg8::EpiF32 E{F_, D}; run_gemm<D, D>(C, HN_, (const bf16*)(ws + WS_WOUT), E); SEAM(8); }
    if (IN(9)) { ph_rownorm(C, 0, 1); SEAM(9); }
    FFN_PHASES(10, 0, WS_WGU_B, WS_WDN_B, 2, true)
    FFN_PHASES(13, 1, WS_WGU_A, WS_WDN_A, 0, false)
    if (IN(16)) { pg8::EpiProj E{BIG_, NIN, (float*)(ws + WS_GATES), -1}; run_gemm<NIN, D>(C, HN_, (const bf16*)(ws + WS_WIN), E); SEAM(16); }
    if (IN(17)) { ph_gla_prep(C); SEAM(17); }
    if (IN(18)) { ph_gla_chunk_prep(C); xcd_barrier(bar); ph_gla_scan2(C); SEAM(18); }
    if (IN(19)) { ph_gla_gate(C); SEAM(19); }
    if (IN(20)) { pg8::EpiF32 E{F_, D}; run_gemm<D, D>(C, HN_, (const bf16*)(ws + WS_WOUT), E); SEAM(20); }
    if (IN(21)) { ph_rownorm(C, 1, 1); SEAM(21); }
    FFN_PHASES(22, 1, WS_WGU_B, WS_WDN_B, 2, false)
}

extern "C" void kernel_launch(void* const* d_in, const int* in_sizes, int n_in, void* d_out, int out_size, void* d_ws, size_t ws_size, hipStream_t stream) {
    static int grid = 0;
    if (grid == 0) {
        if (n_in != 19 || out_size != MR * D || ws_size < WS_END2) { fprintf(stderr, "kernel_launch: unexpected shapes n_in %d out %d ws %zu (need %zu)\n", n_in, out_size, ws_size, (size_t)WS_END2); grid = -1; return; }
        int dev = 0, cus = 0, per_cu = 0;
        if (hipGetDevice(&dev) != hipSuccess || hipDeviceGetAttribute(&cus, hipDeviceAttributeMultiprocessorCount, dev) != hipSuccess) { grid = -1; return; }
        if (hipFuncSetAttribute((const void*)mk_fwd, hipFuncAttributeMaxDynamicSharedMemorySize, LDS_BYTES) != hipSuccess) { fprintf(stderr, "kernel_launch: hipFuncSetAttribute failed\n"); grid = -1; return; }
        if (hipOccupancyMaxActiveBlocksPerMultiprocessor(&per_cu, (const void*)mk_fwd, NTHREADS, LDS_BYTES) != hipSuccess || per_cu < 1) fprintf(stderr, "kernel_launch: occupancy query says %d\n", per_cu);
        (void)hipGetLastError();
        grid = cus;
    }
    if (grid < 0) return;
    (void)hipMemsetAsync((char*)d_ws + WS_CTL, 0, CTL_ZERO_BYTES, stream);
    Args a{};
    for (int i = 0; i < 19; ++i) a.in[i] = (const float*)d_in[i];
    a.out = (float*)d_out; a.ws = (unsigned char*)d_ws;
#if MK_ONE_LAUNCH
    a.ph_lo = 0; a.ph_hi = N_PHASES;
    hipLaunchKernelGGL(mk_fwd, dim3(grid), dim3(NTHREADS), LDS_BYTES, stream, a);
#else
    for (int ph = 0; ph < N_PHASES; ++ph) { a.ph_lo = ph; a.ph_hi = ph + 1; hipLaunchKernelGGL(mk_fwd, dim3(grid), dim3(NTHREADS), LDS_BYTES, stream, a); }
#endif
}
```
